# Optimizing an MI355X kernel written in HIP

```python
import jax, jax.numpy as jnp
from jax import lax
import numpy as np

D_MODEL = 2048
BATCH = 2
SEQ = 8192
DEPTH = 4

HEAD_DIM = 128
D_MIX = D_MODEL
POOL_WIDTH = D_MIX // 4
N_POOL_GROUPS = 4
POOL_GROUP_DIM = POOL_WIDTH // N_POOL_GROUPS
POOL_WINDOWS = (2, 4, 8, 16)
ATTN_WIDTH = D_MIX // 2
N_ATTN_HEADS = ATTN_WIDTH // HEAD_DIM
LRU_WIDTH = D_MIX - POOL_WIDTH - ATTN_WIDTH
N_LRU_BLOCKS = 4
LRU_BLOCK_DIM = LRU_WIDTH // N_LRU_BLOCKS
LRU_CONV_WIDTH = 4
LRU_C = 8.0
D_FF = ((8 * D_MODEL // 3 + 255) // 256) * 256
FFN_CONV_WIDTH = 3
Q_BLOCK = 128
N_IN = POOL_WIDTH + 3 * ATTN_WIDTH + N_ATTN_HEADS + 2 * LRU_WIDTH
EPS = 1e-6

kernel_name = "hymba_style_pool_fox_rglru_convffn"


def rmsnorm(x, g):
    xf = x.astype(jnp.float32)
    y = xf * lax.rsqrt(jnp.mean(xf * xf, axis=-1, keepdims=True) + EPS)
    return (y * g.astype(jnp.float32)).astype(x.dtype)


def causal_dwconv(u, w, b):
    K = w.shape[0]
    S = u.shape[1]
    up = jnp.pad(u, ((0, 0), (K - 1, 0), (0, 0)))
    out = b + up[:, 0:S] * w[0]
    for k in range(1, K):
        out = out + up[:, k:k + S] * w[k]
    return out


def pool_mixer(u, w, scale):
    B, S, _ = u.shape
    uf = u.astype(jnp.float32).reshape(B, S, N_POOL_GROUPS, POOL_GROUP_DIM)
    cs = jnp.cumsum(uf, axis=1)
    pos = jnp.arange(1, S + 1, dtype=jnp.float32)
    outs = []
    for g, win in enumerate(POOL_WINDOWS):
        csg = cs[:, :, g]
        lag = jnp.pad(csg, ((0, 0), (win, 0), (0, 0)))[:, :S]
        mean = (csg - lag) / jnp.minimum(pos, float(win))[None, :, None]
        outs.append(mean - uf[:, :, g])
    d = jnp.stack(outs, axis=2).astype(u.dtype)
    y = jnp.einsum('bsgc,gcd->bsgd', d, w).reshape(B, S, POOL_WIDTH)
    return y * scale


def forgetting_attention(q, k, v, f_logit, b_f):
    B, S, _ = q.shape
    H = N_ATTN_HEADS
    q = q.reshape(B, S, H, HEAD_DIM).transpose(0, 2, 1, 3)
    k = k.reshape(B, S, H, HEAD_DIM).transpose(0, 2, 1, 3)
    v = v.reshape(B, S, H, HEAD_DIM).transpose(0, 2, 1, 3)
    log_f = jax.nn.log_sigmoid(f_logit.astype(jnp.float32) + b_f.astype(jnp.float32))
    F = jnp.cumsum(log_f, axis=1).transpose(0, 2, 1)
    nb = S // Q_BLOCK
    qb = q.reshape(B, H, nb, Q_BLOCK, HEAD_DIM).transpose(2, 0, 1, 3, 4)
    Fb = F.reshape(B, H, nb, Q_BLOCK).transpose(2, 0, 1, 3)
    kpos = jnp.arange(S)
    scale = HEAD_DIM ** -0.5

    def block(args):
        q_blk, F_blk, i = args
        qpos = i * Q_BLOCK + jnp.arange(Q_BLOCK)
        s = (jnp.einsum('bhqd,bhkd->bhqk', q_blk, k).astype(jnp.float32) * scale
             + F_blk[..., None] - F[:, :, None, :])
        s = jnp.where(kpos[None, :] <= qpos[:, None], s, -jnp.inf)
        p = jax.nn.softmax(s, axis=-1).astype(v.dtype)
        return jnp.einsum('bhqk,bhkd->bhqd', p, v)

    o = lax.map(block, (qb, Fb, jnp.arange(nb)))
    return o.transpose(1, 0, 3, 2, 4).reshape(B, S, H * HEAD_DIM)


def rg_lru_branch(xb, yb, conv_w, conv_b, wa, ba, wi, bi, lam):
    B, S, _ = xb.shape
    xc = causal_dwconv(xb, conv_w, conv_b)
    xh = xc.reshape(B, S, N_LRU_BLOCKS, LRU_BLOCK_DIM)
    gate_r = jax.nn.sigmoid((jnp.einsum('bshc,hcd->bshd', xh, wa).reshape(B, S, LRU_WIDTH) + ba).astype(jnp.float32))
    gate_i = jax.nn.sigmoid((jnp.einsum('bshc,hcd->bshd', xh, wi).reshape(B, S, LRU_WIDTH) + bi).astype(jnp.float32))
    log_a = -LRU_C * gate_r * jax.nn.softplus(-lam.astype(jnp.float32))
    a = jnp.exp(log_a)
    inp = jnp.sqrt(-jnp.expm1(2.0 * log_a)) * (gate_i * xc.astype(jnp.float32))

    def combine(left, right):
        a1, b1 = left
        a2, b2 = right
        return a1 * a2, a2 * b1 + b2

    _, h = lax.associative_scan(combine, (a, inp), axis=1)
    return (h * jax.nn.gelu(yb.astype(jnp.float32))).astype(xb.dtype)


def hybrid_mixer(h, w_in, b_f, pool_w, pool_scale, lru_conv_w, lru_conv_b,
                 lru_wa, lru_ba, lru_wi, lru_bi, lru_lambda, w_out):
    z = h @ w_in
    sizes = [POOL_WIDTH, ATTN_WIDTH, ATTN_WIDTH, ATTN_WIDTH, N_ATTN_HEADS, LRU_WIDTH]
    offsets = [int(o) for o in np.cumsum(sizes)]
    zp, zq, zk, zv, zf, zx, zy = jnp.split(z, offsets, axis=-1)
    y_pool = pool_mixer(zp, pool_w, pool_scale)
    y_attn = forgetting_attention(zq, zk, zv, zf, b_f)
    y_lru = rg_lru_branch(zx, zy, lru_conv_w, lru_conv_b, lru_wa, lru_ba, lru_wi, lru_bi, lru_lambda)
    y = jnp.concatenate([y_pool, y_attn.astype(h.dtype), y_lru], axis=-1)
    return y @ w_out


def conv_glu_ffn(h, w_gate, w_up, conv_w, conv_b, w_down):
    g = causal_dwconv(h @ w_gate, conv_w, conv_b)
    return (jax.nn.silu(g) * (h @ w_up)) @ w_down


def setup_inputs(seed: int = 0) -> dict:
    key = jax.random.key(seed)
    ks = jax.random.split(key, 26)
    f32 = jnp.float32

    def nrm(k, shape, s):
        return jax.random.normal(k, shape, f32) * s

    u_lam = jax.random.uniform(ks[15], (DEPTH, LRU_WIDTH), f32, 0.9, 0.999)
    s_lam = u_lam ** (1.0 / LRU_C)
    lru_lambda = jnp.log(s_lam) - jnp.log1p(-s_lam)
    return {
        "x": nrm(ks[0], (BATCH, SEQ, D_MODEL), 1.0),
        "c": nrm(ks[1], (BATCH, D_MODEL), 1.0),
        "w_ada": nrm(ks[2], (DEPTH, D_MODEL, 6 * D_MODEL), 0.5 * D_MODEL ** -0.5),
        "b_ada": nrm(ks[3], (DEPTH, 6 * D_MODEL), 0.01),
        "g_mix": 1.0 + nrm(ks[4], (DEPTH, D_MODEL), 0.05),
        "w_in": nrm(ks[5], (DEPTH, D_MODEL, N_IN), D_MODEL ** -0.5),
        "b_f": jax.random.uniform(ks[6], (DEPTH, N_ATTN_HEADS), f32, 1.0, 5.0),
        "pool_w": nrm(ks[7], (DEPTH, N_POOL_GROUPS, POOL_GROUP_DIM, POOL_GROUP_DIM), POOL_GROUP_DIM ** -0.5),
        "pool_scale": 1.0 + nrm(ks[8], (DEPTH, POOL_WIDTH), 0.1),
        "lru_conv_w": nrm(ks[9], (DEPTH, LRU_CONV_WIDTH, LRU_WIDTH), LRU_CONV_WIDTH ** -0.5),
        "lru_conv_b": nrm(ks[10], (DEPTH, LRU_WIDTH), 0.01),
        "lru_wa": nrm(ks[11], (DEPTH, N_LRU_BLOCKS, LRU_BLOCK_DIM, LRU_BLOCK_DIM), LRU_BLOCK_DIM ** -0.5),
        "lru_ba": nrm(ks[12], (DEPTH, LRU_WIDTH), 0.01),
        "lru_wi": nrm(ks[13], (DEPTH, N_LRU_BLOCKS, LRU_BLOCK_DIM, LRU_BLOCK_DIM), LRU_BLOCK_DIM ** -0.5),
        "lru_bi": nrm(ks[14], (DEPTH, LRU_WIDTH), 0.01),
        "lru_lambda": lru_lambda,
        "w_out": nrm(ks[16], (DEPTH, D_MIX, D_MODEL), D_MIX ** -0.5),
        "g_ffn": 1.0 + nrm(ks[17], (DEPTH, D_MODEL), 0.05),
        "w_ffn_gate": nrm(ks[18], (DEPTH, D_MODEL, D_FF), D_MODEL ** -0.5),
        "w_ffn_up": nrm(ks[19], (DEPTH, D_MODEL, D_FF), D_MODEL ** -0.5),
        "ffn_conv_w": nrm(ks[20], (DEPTH, FFN_CONV_WIDTH, D_FF), FFN_CONV_WIDTH ** -0.5),
        "ffn_conv_b": nrm(ks[21], (DEPTH, D_FF), 0.01),
        "w_ffn_down": nrm(ks[22], (DEPTH, D_FF, D_MODEL), D_FF ** -0.5),
        "final_g": 1.0 + nrm(ks[23], (D_MODEL,), 0.05),
    }


def reference(x, c, w_ada, b_ada, g_mix, w_in, b_f, pool_w, pool_scale, lru_conv_w, lru_conv_b,
              lru_wa, lru_ba, lru_wi, lru_bi, lru_lambda, w_out, g_ffn, w_ffn_gate, w_ffn_up,
              ffn_conv_w, ffn_conv_b, w_ffn_down, final_g):
    c_act = jax.nn.silu(c)
    for l in range(DEPTH):
        mod = c_act @ w_ada[l] + b_ada[l]
        sh1, sc1, gt1, sh2, sc2, gt2 = jnp.split(mod[:, None, :], 6, axis=-1)
        h = rmsnorm(x, g_mix[l]) * (1.0 + sc1) + sh1
        x = x + gt1 * hybrid_mixer(h, w_in[l], b_f[l], pool_w[l], pool_scale[l], lru_conv_w[l], lru_conv_b[l],
                                   lru_wa[l], lru_ba[l], lru_wi[l], lru_bi[l], lru_lambda[l], w_out[l])
        h = rmsnorm(x, g_ffn[l]) * (1.0 + sc2) + sh2
        x = x + gt2 * conv_glu_ffn(h, w_ffn_gate[l], w_ffn_up[l], ffn_conv_w[l], ffn_conv_b[l], w_ffn_down[l])
    return rmsnorm(x, final_g)
```

```cpp
#include <hip/hip_runtime.h>
#include <cstdio>
#include <cstdint>

typedef unsigned short bf16_t;
typedef short bf16x8 __attribute__((ext_vector_type(8)));
typedef float f32x4 __attribute__((ext_vector_type(4)));

constexpr int SEQ = 8192, DM = 2048, DEPTH = 4, M = 2 * SEQ;
constexpr int PW = 512, LW = 512, DFF = 5632, NIN = 4616, NZ = 4608, NGU = 2 * DFF;
constexpr int NADA = 6 * DM;

constexpr size_t MiB = (size_t)1 << 20;
constexpr size_t WS_CTL = 0, WS_MOD = 1 * MiB, WS_WIN = 8 * MiB, WS_WOUT = 80 * MiB, WS_WGU = 112 * MiB, WS_WDN = 288 * MiB, WS_WSM = 376 * MiB;
constexpr size_t WS_H = 378 * MiB, WS_Q = 442 * MiB, WS_K = 474 * MiB, WS_V = 506 * MiB, WS_ZP = 538 * MiB, WS_ZX = 554 * MiB, WS_ZY = 570 * MiB;
constexpr size_t WS_FL = 586 * MiB, WS_F = 587 * MiB, WS_Y = 588 * MiB, WS_ACT = 652 * MiB, WS_LRUA = 828 * MiB, WS_LRUB = 860 * MiB;
constexpr size_t WS_XC = 908 * MiB, WS_SCR = 988 * MiB, WS_END = 1372 * MiB;

__device__ __forceinline__ bf16_t f2bf(float f) { unsigned u = __float_as_uint(f); return (bf16_t)((u + 0x7fffu + ((u >> 16) & 1u)) >> 16); }
__device__ __forceinline__ float log_sigmoidf_(float x) { return fminf(x, 0.f) - log1pf(expf(-fabsf(x))); }

#include <cstring>
__device__ __forceinline__ int opaque_tid() { int t = threadIdx.x; asm volatile("" : "+v"(t)); return t; }

namespace pg8 {
#define PG8_LAS __attribute__((address_space(3)))
typedef unsigned short bf16_t;
typedef short bf16x8 __attribute__((ext_vector_type(8)));
typedef float f32x4 __attribute__((ext_vector_type(4)));
typedef unsigned u32x4 __attribute__((ext_vector_type(4)));
constexpr int BM = 256, BK = 64, HALF = 128, HTB = HALF * BK * 2  , STAGE_BYTES = 8 * HTB, NXCD = 8, WGM = 8;

__host__ __device__ __forceinline__ int lds_byte(int r, int c) { const int st = (r >> 4) * 2 + (c >> 5), rr = r & 15, cc = c & 31, ob = rr * 64 + cc * 2; return st * 1024 + (ob ^ (((ob >> 9) & 1) << 5)); }
__host__ __device__ __forceinline__ void stage_rc(int b, int& R, int& C) { const int st = b / 1024, sb = b % 1024, swz = sb ^ (((sb >> 9) & 1) << 5); R = (st >> 1) * 16 + swz / 64; C = (st & 1) * 32 + (swz % 64) / 2; }
__host__ __device__ __forceinline__ int perm32(int rho) { const int n = rho >> 4, i = rho & 15; return 8 * (i >> 2) + 4 * n + (i & 3); }

struct Unit { int pm, pn; };
struct Gemm { const bf16_t* A; const bf16_t* Bt; int M, N, K; };

struct StaticOrder {
    int nM, nN, nwg, G, c;
    __host__ __device__ __forceinline__ void init(int M, int N, int G_, int c_) { nM = M / BM; nN = N / BM; nwg = nM * nN; G = G_; c = c_; }
    __host__ __device__ __forceinline__ bool next(int i, Unit& u) const {
        const long L = (long)i * G + c; if (L >= nwg) return false;
        int wgid = (int)L; { const int q = nwg / NXCD, r = nwg % NXCD, xcd = wgid % NXCD, off = wgid / NXCD; wgid = (xcd < r ? xcd * (q + 1) : r * (q + 1) + (xcd - r) * q) + off; }
        const int nig = WGM * nN, gid = wgid / nig, fm = gid * WGM, gsz = (nM - fm) < WGM ? (nM - fm) : WGM;
        u.pm = fm + ((wgid % nig) % gsz); u.pn = (wgid % nig) / gsz; return true;
    }
    __device__ __forceinline__ void a_ready(const Unit&) const {}
    __device__ __forceinline__ void done(const Unit&) const {}
};

__device__ __forceinline__ unsigned cvt_pk_bf16(float lo, float hi) { unsigned r; asm volatile("v_cvt_pk_bf16_f32 %0, %1, %2" : "=v"(r) : "v"(lo), "v"(hi)); return r; }


struct EpiZr {
    static constexpr bool PERM = true, AFTER_DRAIN = false;
    static constexpr size_t QKV_STRIDE = (size_t)16 << 20;
    bf16_t *zp, *q, *zx, *zy; unsigned* nrm; PG8_LAS float* nrmp;
    __device__ __forceinline__ void operator()(const f32x4 (&acc)[2][2][4][2], const Unit& u, int wr, int wc, int fr, int fq) const {
        const int r0 = u.pm * BM, bb = r0 >> 13, s0 = r0 & 8191;
#pragma unroll
        for (int bj = 0; bj < 2; ++bj) {
            const int cb = u.pn * 2 + bj; bf16_t* base; int stride;
            if (cb < 4) { base = zp + (size_t)r0 * 512 + cb * 128; stride = 512; }
            else if (cb < 28) { const int t = (cb - 4) >> 3, hh = (cb - 4) & 7; base = q + (size_t)t * QKV_STRIDE + ((size_t)(bb * 8 + hh) * 8192 + s0) * 128; stride = 128; }
            else if (cb < 32) { base = zx + (size_t)r0 * 512 + (cb - 28) * 128; stride = 512; }
            else { base = zy + (size_t)r0 * 512 + (cb - 32) * 128; stride = 512; }
            base += wc * 32 + 8 * fq;
#pragma unroll
            for (int ai = 0; ai < 2; ++ai)
#pragma unroll
                for (int m = 0; m < 4; ++m) { const int lr = ai * HALF + wr * 64 + m * 16 + fr; const f32x4 v0 = acc[ai][bj][m][0], v1 = acc[ai][bj][m][1];
                    u32x4 w; w.x = cvt_pk_bf16(v0[0], v0[1]); w.y = cvt_pk_bf16(v0[2], v0[3]); w.z = cvt_pk_bf16(v1[0], v1[1]); w.w = cvt_pk_bf16(v1[2], v1[3]);
                    *(u32x4*)(base + (size_t)lr * stride) = w; }
            if (cb >= 4 && cb < 20) {
#pragma unroll
                for (int ai = 0; ai < 2; ++ai)
#pragma unroll
                    for (int m = 0; m < 4; ++m) { const f32x4 v0 = acc[ai][bj][m][0], v1 = acc[ai][bj][m][1];
                        float ss = (v0[0] * v0[0] + v0[1] * v0[1]) + (v0[2] * v0[2] + v0[3] * v0[3]) + (v1[0] * v1[0] + v1[1] * v1[1]) + (v1[2] * v1[2] + v1[3] * v1[3]);
                        ss += __builtin_bit_cast(float, __builtin_amdgcn_ds_swizzle(__builtin_bit_cast(int, ss), 0x401f));
                        { const auto rr = __builtin_amdgcn_permlane32_swap(__builtin_bit_cast(unsigned, ss), __builtin_bit_cast(unsigned, ss), false, false); ss = __builtin_bit_cast(float, rr[0]) + __builtin_bit_cast(float, rr[1]); }
                        if (fq == 0) nrmp[bj * 1024 + (ai * HALF + wr * 64 + m * 16 + fr) * 4 + wc] = ss; }
            }
        }
        if (u.pn >= 2 && u.pn < 10) {
            asm volatile("s_waitcnt lgkmcnt(0)" ::: "memory"); __builtin_amdgcn_s_barrier(); asm volatile("" ::: "memory");
            const int t_ = (wr * 4 + wc) * 64 + fq * 16 + fr; const f32x4 p4 = *(const PG8_LAS f32x4*)(nrmp + t_ * 4);
            float mx = (p4[0] + p4[1]) + (p4[2] + p4[3]);
            mx = fmaxf(mx, __builtin_bit_cast(float, __builtin_amdgcn_ds_swizzle(__builtin_bit_cast(int, mx), 0x041f)));
            mx = fmaxf(mx, __builtin_bit_cast(float, __builtin_amdgcn_ds_swizzle(__builtin_bit_cast(int, mx), 0x081f)));
            mx = fmaxf(mx, __builtin_bit_cast(float, __builtin_amdgcn_ds_swizzle(__builtin_bit_cast(int, mx), 0x101f)));
            mx = fmaxf(mx, __builtin_bit_cast(float, __builtin_amdgcn_ds_swizzle(__builtin_bit_cast(int, mx), 0x201f)));
            mx = fmaxf(mx, __builtin_bit_cast(float, __builtin_amdgcn_ds_swizzle(__builtin_bit_cast(int, mx), 0x401f)));
            { const auto rr = __builtin_amdgcn_permlane32_swap(__builtin_bit_cast(unsigned, mx), __builtin_bit_cast(unsigned, mx), false, false); mx = fmaxf(__builtin_bit_cast(float, rr[0]), __builtin_bit_cast(float, rr[1])); }
            if (fr == 0 && fq == 0) { const int cb = u.pn * 2 + wr  , t = (cb - 4) >> 3, hh = (cb - 4) & 7; atomicMax(nrm + ((bb * 8 + hh) * 2 + t) * 4, __builtin_bit_cast(unsigned, mx)); }
        }
    }
};
template <int N> __device__ __forceinline__ float conv_prev(float oldv, float cur) {
    return __builtin_bit_cast(float, __builtin_amdgcn_update_dpp(__builtin_bit_cast(int, oldv), __builtin_bit_cast(int, cur), 0x110 + N, 0xf, 0xf, false));
}
template <int N> __device__ __forceinline__ float row_ror(float v) { return __builtin_bit_cast(float, __builtin_amdgcn_update_dpp(0, __builtin_bit_cast(int, v), 0x120 + N, 0xf, 0xf, false)); }
struct EpiGUAct {
    static constexpr bool PERM = true, AFTER_DRAIN = false;
    bf16_t* act; const float* cw; const float* cb; float* side; PG8_LAS float* halo;
    __device__ __forceinline__ void operator()(const f32x4 (&acc)[2][2][4][2], const Unit& u, int wr, int wc, int fr, int fq) const {
        const int ch0 = u.pn * 128 + wc * 32 + 8 * fq, lc0 = wc * 32 + 8 * fq;
        f32x4 w0[2], w1[2], w2[2], bb[2];
#pragma unroll
        for (int n = 0; n < 2; ++n) { w0[n] = *(const f32x4*)(cw + ch0 + 4 * n); w1[n] = *(const f32x4*)(cw + 5632 + ch0 + 4 * n); w2[n] = *(const f32x4*)(cw + 2 * 5632 + ch0 + 4 * n); bb[n] = *(const f32x4*)(cb + ch0 + 4 * n); }
        if (fr >= 14) {
#pragma unroll
            for (int ai = 0; ai < 2; ++ai) { PG8_LAS float* hp = halo + ((2 * ai + wr) * 2 + (fr - 14)) * 128 + lc0; *(PG8_LAS f32x4*)hp = acc[ai][0][3][0]; *(PG8_LAS f32x4*)(hp + 4) = acc[ai][0][3][1]; }
            if (wr == 1) { float* sp = side + ((size_t)u.pm * 6 + 4 + (fr - 14)) * 5632 + ch0; *(f32x4*)sp = acc[1][0][3][0]; *(f32x4*)(sp + 4) = acc[1][0][3][1]; }
        }
        if (wr == 0 && fr < 2) { float* sp = side + ((size_t)u.pm * 6 + fr) * 5632 + ch0; *(f32x4*)sp = acc[0][0][0][0]; *(f32x4*)(sp + 4) = acc[0][0][0][1];
            sp += 2 * 5632; *(f32x4*)sp = acc[0][1][0][0]; *(f32x4*)(sp + 4) = acc[0][1][0][1]; }
        asm volatile("s_waitcnt lgkmcnt(0)" ::: "memory"); __builtin_amdgcn_s_barrier(); asm volatile("" ::: "memory");
#pragma unroll
        for (int ai = 0; ai < 2; ++ai) {
            const int s = 2 * ai + wr; f32x4 o1[2], o2[2];
            if (s > 0) { const PG8_LAS float* hp = halo + ((s - 1) * 2) * 128 + lc0;
#pragma unroll
                for (int n = 0; n < 2; ++n) { const f32x4 r62 = *(const PG8_LAS f32x4*)(hp + 4 * n), r63 = *(const PG8_LAS f32x4*)(hp + 128 + 4 * n); o1[n] = r63; o2[n] = fr == 0 ? r62 : r63; } }
            else { o1[0] = o1[1] = o2[0] = o2[1] = (f32x4){0.f, 0.f, 0.f, 0.f}; }
#pragma unroll
            for (int m = 0; m < 4; ++m) { unsigned pk[4];
#pragma unroll
                for (int n = 0; n < 2; ++n) { const f32x4 cur = acc[ai][0][m][n], up = acc[ai][1][m][n]; float a[4];
#pragma unroll
                    for (int e = 0; e < 4; ++e) {
                        const float p1 = conv_prev<1>(o1[n][e], cur[e]), p2 = conv_prev<2>(o2[n][e], cur[e]);
                        const float g = bb[n][e] + w0[n][e] * p2 + w1[n][e] * p1 + w2[n][e] * cur[e];
                        a[e] = g * __builtin_amdgcn_rcpf(1.f + __builtin_amdgcn_exp2f(-1.4426950408889634f * g)) * up[e];
                        o1[n][e] = row_ror<1>(cur[e]); o2[n][e] = row_ror<2>(cur[e]); }
                    pk[2 * n] = cvt_pk_bf16(a[0], a[1]); pk[2 * n + 1] = cvt_pk_bf16(a[2], a[3]); }
                if (!(s == 0 && m == 0 && fr < 2)) *(u32x4*)(act + (size_t)(u.pm * BM + ai * HALF + wr * 64 + m * 16 + fr) * 5632 + ch0) = (u32x4){pk[0], pk[1], pk[2], pk[3]}; }
        }
    }
};
typedef _Float16 h16x4 __attribute__((ext_vector_type(4)));
typedef _Float16 h16x8 __attribute__((ext_vector_type(8)));
__device__ __forceinline__ f32x4 ldh4(const _Float16* p) { const h16x4 h = *(const h16x4*)p; return __builtin_convertvector(h, f32x4); }
__device__ __forceinline__ void sth4(_Float16* p, f32x4 v) { *(h16x4*)p = __builtin_convertvector(v, h16x4); }
template <bool XF32>
struct EpiResid {
    static constexpr bool PERM = true, AFTER_DRAIN = false;
    const float* xin; const _Float16* xh; _Float16* xout; const float* gate;
    __device__ __forceinline__ void operator()(const f32x4 (&acc)[2][2][4][2], const Unit& u, int wr, int wc, int fr, int fq) const {
        const int col0 = u.pn * BM + wc * 32 + 8 * fq; const float* gp = gate + ((u.pm * BM) >> 13) * 12288 + col0;
        f32x4 gv[2][2];
#pragma unroll
        for (int bj = 0; bj < 2; ++bj)
#pragma unroll
            for (int n = 0; n < 2; ++n) gv[bj][n] = *(const f32x4*)(gp + bj * HALF + n * 4);
        const unsigned row0 = u.pm * BM + wr * 64 + fr;
        if constexpr (XF32) {
#pragma unroll
            for (int ai = 0; ai < 2; ++ai)
#pragma unroll
                for (int m = 0; m < 4; ++m) { const size_t off = (size_t)(row0 + ai * HALF + m * 16) * 2048 + col0;
#pragma unroll
                    for (int bj = 0; bj < 2; ++bj) { const f32x4 x0 = *(const f32x4*)(xin + off + bj * HALF), x1 = *(const f32x4*)(xin + off + bj * HALF + 4);
                        const h16x4 r0 = __builtin_convertvector(x0 + gv[bj][0] * acc[ai][bj][m][0], h16x4), r1 = __builtin_convertvector(x1 + gv[bj][1] * acc[ai][bj][m][1], h16x4);
                        *(h16x8*)(xout + off + bj * HALF) = __builtin_shufflevector(r0, r1, 0, 1, 2, 3, 4, 5, 6, 7); }
                    if (m == 3) asm volatile("" ::: "memory"); }
        } else {
            h16x8 xr[2][4][2];
#pragma unroll
            for (int ai = 0; ai < 2; ++ai)
#pragma unroll
                for (int m = 0; m < 4; ++m) { const size_t off = (size_t)(row0 + ai * HALF + m * 16) * 2048 + col0;
#pragma unroll
                    for (int bj = 0; bj < 2; ++bj) xr[ai][m][bj] = *(const h16x8*)(xh + off + bj * HALF); }
            asm volatile("" ::: "memory");
#pragma unroll
            for (int ai = 0; ai < 2; ++ai)
#pragma unroll
                for (int m = 0; m < 4; ++m) { const size_t off = (size_t)(row0 + ai * HALF + m * 16) * 2048 + col0;
#pragma unroll
                    for (int bj = 0; bj < 2; ++bj) { const h16x8 xv = xr[ai][m][bj];
                        const f32x4 x0 = __builtin_convertvector(__builtin_shufflevector(xv, xv, 0, 1, 2, 3), f32x4), x1 = __builtin_convertvector(__builtin_shufflevector(xv, xv, 4, 5, 6, 7), f32x4);
                        const h16x4 r0 = __builtin_convertvector(x0 + gv[bj][0] * acc[ai][bj][m][0], h16x4), r1 = __builtin_convertvector(x1 + gv[bj][1] * acc[ai][bj][m][1], h16x4);
                        *(h16x8*)(xout + off + bj * HALF) = __builtin_shufflevector(r0, r1, 0, 1, 2, 3, 4, 5, 6, 7); } }
        }
    }
};

template <class Epi, class Sched, bool ALIGN_EPI = false, bool SP2 = false>
__device__ __forceinline__ void gemm_phase(PG8_LAS unsigned char* lds, const Gemm g, const Sched& S, const Epi& E) {
    const int tid = opaque_tid(), wid = __builtin_amdgcn_readfirstlane(tid >> 6), lane = tid & 63, wr = wid >> 2, wc = wid & 3, fr = lane & 15, fq = lane >> 4;
    const int K = g.K, nt = K / BK;
    unsigned voffA[2], voffB[2];
#pragma unroll
    for (int i = 0; i < 2; ++i) { int R, C; stage_rc(tid * 16 + i * 8192, R, C); const int Rb = Epi::PERM ? ((R & ~31) + perm32(R & 31)) : R;
        voffA[i] = (unsigned)(R * K + C) * 2u; voffB[i] = (unsigned)(Rb * K + C) * 2u; }
    const size_t kstep = (size_t)(BK * 2);
    const size_t hstep = (size_t)HALF * K * 2;
    const size_t tstep = 2 * hstep;
    const unsigned ldsw = (unsigned)wid * 1024u;
    const int aoff = lds_byte(wr * 64 + fr, fq * 8), boff = lds_byte(wc * 32 + fr, fq * 8);
#define PG8_SA(b, h) (((b) * 2 + (h)) * HTB)
#define PG8_SB(b, h) ((4 + (b) * 2 + (h)) * HTB)
#define PG8_STAGE(bufoff, gbase, voff) do { _Pragma("unroll") for (int _i = 0; _i < 2; ++_i) \
        __builtin_amdgcn_global_load_lds((const unsigned*)((const char*)(gbase) + (voff)[_i]), (PG8_LAS unsigned*)(lds + (bufoff) + ldsw + _i * 8192), 16, 0, 0); } while (0)
#define PG8_LDA(dst, b, h) do { _Pragma("unroll") for (int m = 0; m < 4; ++m) _Pragma("unroll") for (int k = 0; k < 2; ++k) dst[m][k] = *(const PG8_LAS bf16x8*)(lds + PG8_SA(b, h) + aoff + m * 2048 + k * 1024); } while (0)
#define PG8_LDB(dst, b, h) do { _Pragma("unroll") for (int n = 0; n < 2; ++n) _Pragma("unroll") for (int k = 0; k < 2; ++k) dst[n][k] = *(const PG8_LAS bf16x8*)(lds + PG8_SB(b, h) + boff + n * 2048 + k * 1024); } while (0)
#define PG8_MMA(ai, bj, At, Bt) do { __builtin_amdgcn_s_setprio(1); _Pragma("unroll") for (int m = 0; m < 4; ++m) _Pragma("unroll") for (int n = 0; n < 2; ++n) _Pragma("unroll") for (int k = 0; k < 2; ++k) \
        acc[ai][bj][m][n] = __builtin_amdgcn_mfma_f32_16x16x32_bf16(Bt[n][k], At[m][k], acc[ai][bj][m][n], 0, 0, 0); __builtin_amdgcn_s_setprio(0); } while (0)
#define PG8_WAIT_V(n) asm volatile("s_waitcnt vmcnt(" #n ")" ::: "memory")
#define PG8_WAIT_L(n) asm volatile("s_waitcnt lgkmcnt(" #n ")" ::: "memory")
#define PG8_BAR __builtin_amdgcn_s_barrier()
#define PG8_SCHED __builtin_amdgcn_sched_barrier(0)
    Unit cur, nxt; int ui = 0;
    if (!S.next(0, cur)) return;
    f32x4 acc[2][2][4][2];
#pragma unroll
    for (int a = 0; a < 2; ++a)
#pragma unroll
        for (int b = 0; b < 2; ++b)
#pragma unroll
            for (int m = 0; m < 4; ++m)
#pragma unroll
                for (int n = 0; n < 2; ++n) acc[a][b][m][n] = (f32x4){0.f, 0.f, 0.f, 0.f};
    bf16x8 At[4][2], B0[2][2], B1[2][2];
    const char* cA = (const char*)g.A + (size_t)cur.pm * tstep; const char* cB = (const char*)g.Bt + (size_t)cur.pn * tstep;
    S.a_ready(cur);
    if constexpr (SP2) {
        PG8_STAGE(PG8_SB(0, 0), cB, voffB); PG8_STAGE(PG8_SB(0, 1), cB + hstep, voffB); PG8_STAGE(PG8_SA(0, 0), cA, voffA); PG8_STAGE(PG8_SA(0, 1), cA + hstep, voffA);
        if (wr == 1) PG8_BAR;
        PG8_WAIT_V(2); PG8_BAR;
        PG8_STAGE(PG8_SB(1, 0), cB + kstep, voffB); PG8_STAGE(PG8_SA(1, 0), cA + kstep, voffA); PG8_STAGE(PG8_SB(1, 1), cB + hstep + kstep, voffB);
        PG8_WAIT_V(6); PG8_BAR;
    } else {
        PG8_STAGE(PG8_SB(0, 0), cB, voffB); PG8_STAGE(PG8_SA(0, 0), cA, voffA); PG8_STAGE(PG8_SB(0, 1), cB + hstep, voffB); PG8_STAGE(PG8_SA(0, 1), cA + hstep, voffA);
        if (wr == 1) PG8_BAR;
        PG8_WAIT_V(4); PG8_BAR;
        PG8_STAGE(PG8_SB(1, 0), cB + kstep, voffB); PG8_STAGE(PG8_SA(1, 0), cA + kstep, voffA); PG8_STAGE(PG8_SB(1, 1), cB + hstep + kstep, voffB);
        PG8_WAIT_V(6); PG8_BAR;
    }
    for (;;) {
        const bool has_next = S.next(ui + 1, nxt);
        const char* nA = has_next ? (const char*)g.A + (size_t)nxt.pm * tstep : cA; const char* nB = has_next ? (const char*)g.Bt + (size_t)nxt.pn * tstep : cB;
        for (int t = 0; t < nt; t += 2) {
            const bool last = (t == nt - 2);
            const char* a1 = cA + (size_t)(t + 1) * kstep;
            const char* a2 = last ? nA : cA + (size_t)(t + 2) * kstep; const char* b2 = last ? nB : cB + (size_t)(t + 2) * kstep;
            const char* a3 = a2 + kstep; const char* b3 = b2 + kstep;
            if (last && has_next) S.a_ready(nxt);
            if constexpr (SP2) {
            PG8_LDB(B0, 0, 0); PG8_LDB(B1, 0, 1); PG8_SCHED; PG8_LDA(At, 0, 0); PG8_STAGE(PG8_SA(1, 1), a1 + hstep, voffA);
            PG8_WAIT_V(8); PG8_WAIT_L(0); PG8_BAR; PG8_MMA(0, 0, At, B0); PG8_MMA(0, 1, At, B1); PG8_BAR; PG8_SCHED;
            PG8_LDA(At, 0, 1); PG8_STAGE(PG8_SB(0, 0), b2, voffB); PG8_STAGE(PG8_SB(0, 1), b2 + hstep, voffB); PG8_STAGE(PG8_SA(0, 0), a2, voffA);
            PG8_WAIT_V(8); PG8_WAIT_L(0); PG8_BAR; PG8_MMA(1, 0, At, B0); PG8_MMA(1, 1, At, B1); PG8_BAR; PG8_SCHED;
            PG8_LDB(B0, 1, 0); PG8_LDB(B1, 1, 1); PG8_SCHED; PG8_LDA(At, 1, 0); PG8_STAGE(PG8_SA(0, 1), a2 + hstep, voffA);
            PG8_WAIT_V(8); PG8_WAIT_L(0); PG8_BAR; PG8_MMA(0, 0, At, B0); PG8_MMA(0, 1, At, B1); PG8_BAR; PG8_SCHED;
            PG8_LDA(At, 1, 1); PG8_STAGE(PG8_SB(1, 0), b3, voffB); PG8_STAGE(PG8_SB(1, 1), b3 + hstep, voffB); PG8_STAGE(PG8_SA(1, 0), a3, voffA);
            PG8_WAIT_V(8); PG8_WAIT_L(0); PG8_BAR; PG8_MMA(1, 0, At, B0); PG8_MMA(1, 1, At, B1); PG8_BAR; PG8_SCHED;
            } else {
            PG8_LDB(B0, 0, 0); PG8_SCHED; PG8_LDA(At, 0, 0); PG8_STAGE(PG8_SA(1, 1), a1 + hstep, voffA);
            PG8_WAIT_L(8); PG8_BAR; PG8_WAIT_L(0); PG8_MMA(0, 0, At, B0); PG8_BAR; PG8_SCHED;
            PG8_LDB(B1, 0, 1); PG8_STAGE(PG8_SB(0, 0), b2, voffB);
            PG8_BAR; PG8_WAIT_L(0); PG8_MMA(0, 1, At, B1); PG8_BAR;
            PG8_LDA(At, 0, 1); PG8_STAGE(PG8_SA(0, 0), a2, voffA);
            PG8_BAR; PG8_WAIT_L(0); PG8_MMA(1, 0, At, B0); PG8_BAR; PG8_SCHED;
            PG8_STAGE(PG8_SB(0, 1), b2 + hstep, voffB);
            PG8_WAIT_V(6); PG8_BAR; PG8_MMA(1, 1, At, B1); PG8_BAR;
            PG8_LDB(B0, 1, 0); PG8_SCHED; PG8_LDA(At, 1, 0); PG8_STAGE(PG8_SA(0, 1), a2 + hstep, voffA);
            PG8_WAIT_L(8); PG8_BAR; PG8_WAIT_L(0); PG8_MMA(0, 0, At, B0); PG8_BAR; PG8_SCHED;
            PG8_LDB(B1, 1, 1); PG8_STAGE(PG8_SB(1, 0), b3, voffB);
            PG8_BAR; PG8_WAIT_L(0); PG8_MMA(0, 1, At, B1); PG8_BAR;
            PG8_LDA(At, 1, 1); PG8_STAGE(PG8_SA(1, 0), a3, voffA);
            PG8_BAR; PG8_WAIT_L(0); PG8_MMA(1, 0, At, B0); PG8_BAR; PG8_SCHED;
            PG8_STAGE(PG8_SB(1, 1), b3 + hstep, voffB);
            PG8_WAIT_V(6); PG8_BAR; PG8_MMA(1, 1, At, B1); PG8_BAR;
            }
        }
        if constexpr (ALIGN_EPI) { if (wr == 0) PG8_BAR; }
        if constexpr (!Epi::AFTER_DRAIN) { E(acc, cur, wr, wc, fr, fq); S.done(cur); }
        if (!has_next) break;
#pragma unroll
        for (int a = 0; a < 2; ++a)
#pragma unroll
            for (int b = 0; b < 2; ++b)
#pragma unroll
                for (int m = 0; m < 4; ++m)
#pragma unroll
                    for (int n = 0; n < 2; ++n) acc[a][b][m][n] = (f32x4){0.f, 0.f, 0.f, 0.f};
        cur = nxt; cA = nA; cB = nB; ++ui;
        if constexpr (ALIGN_EPI) { if (wr == 1) PG8_BAR; }
    }
    PG8_WAIT_V(0);
    if constexpr (!ALIGN_EPI) { if (wr == 0) PG8_BAR; }
    PG8_BAR;
    if constexpr (Epi::AFTER_DRAIN) { E.fused(acc, cur, wr, wc, fr, fq, lds, wid, lane); S.done(cur); }
#undef PG8_SA
#undef PG8_SB
#undef PG8_STAGE
#undef PG8_LDA
#undef PG8_LDB
#undef PG8_MMA
#undef PG8_WAIT_V
#undef PG8_WAIT_L
#undef PG8_BAR
#undef PG8_SCHED
}
}

namespace fox {
constexpr int D = 128, LDO = 2048;
constexpr float THR = 8.f; constexpr bool WSKIP = false;
constexpr float SCALE = 0.08838834764831845f, RSCALE = 11.313708498984761f;
constexpr int NW = 8, QBLK = 32, KVBLK = 64, QB = NW * QBLK;
constexpr int SHM_V = KVBLK * D * 2, SHM_K = KVBLK * D * 2;
constexpr int LDS_BIAS = 2 * SHM_V + 2 * SHM_K + NW * 64 * 4;
constexpr int LDS_OSTG = 81920;
typedef unsigned uint4_t __attribute__((ext_vector_type(4)));
constexpr int LDS_BYTES = LDS_BIAS + 2 * 256;
using bf16 = unsigned short;
typedef short bf16x8 __attribute__((ext_vector_type(8)));
typedef short s16x4 __attribute__((ext_vector_type(4)));
typedef float f32x16 __attribute__((ext_vector_type(16)));
typedef float f32x4 __attribute__((ext_vector_type(4)));
typedef unsigned u32x4 __attribute__((ext_vector_type(4)));
template <class A, class Bt> struct same_t { static constexpr bool v = false; };
template <class A> struct same_t<A, A> { static constexpr bool v = true; };

#define KSWZ(row, colB) ((row) * 256 + ((colB) ^ (((row) & 7) << 4)))
#define SBAR() __builtin_amdgcn_sched_barrier(0)
__device__ __forceinline__ int v_st(int k, int c) { const int kk = (k & ~0xC) | ((k & 4) << 1) | ((k & 8) >> 1); return ((kk >> 3) * 4 + (c >> 5)) * 512 + ((kk & 7) * 32 + (c & 31)) * 2; }
__device__ __forceinline__ int v_rd_base(int lane) { return ((lane & 3) << 3) | (((lane >> 2) & 3) << 6) | (((lane >> 4) & 1) << 5) | (((lane >> 5) & 1) << 8); }
constexpr int v_rd_off(int d0, int ks, int half) { return d0 * 512 + ks * 4096 + half * 2048; }
__device__ __forceinline__ int crow(int r, int hi) { return (r & 3) + 8 * (r >> 2) + 4 * hi; }
__device__ __forceinline__ unsigned cvtpk(float lo, float hi) {
    unsigned r; asm volatile("v_cvt_pk_bf16_f32 %0, %1, %2" : "=v"(r) : "v"(lo), "v"(hi)); return r;
}
__device__ __forceinline__ bf16x8 pack8(f32x4 a, f32x4 b) {
    u32x4 w = {cvtpk(a[0], a[1]), cvtpk(a[2], a[3]), cvtpk(b[0], b[1]), cvtpk(b[2], b[3])};
    return *reinterpret_cast<bf16x8*>(&w);
}
template <class T> __device__ __forceinline__ bf16x8 load8(const T* p) {
    if constexpr (same_t<T, float>::v) { return pack8(*(const f32x4*)p, *(const f32x4*)(p + 4)); }
    else { return *reinterpret_cast<const bf16x8*>(p); }
}
__device__ __forceinline__ void mask_tile(f32x16& p0, f32x16& p1, int dq, unsigned W) {
    const float NEG = -__builtin_inff();
#pragma unroll
    for (int r = 0; r < 16; ++r) {
        const int c = (r & 3) + 8 * (r >> 2);
        if ((unsigned)(dq - c) >= W) p0[r] = NEG;
        if ((unsigned)(dq - c - 32) >= W) p1[r] = NEG;
    }
}
__device__ __forceinline__ void partialSM(f32x16& p0, f32x16& p1, float& m_reg, float& mn, float& alpha) {
    float pmax = p0[0]; for (int r = 1; r < 16; ++r) pmax = fmaxf(pmax, p0[r]); for (int r = 0; r < 16; ++r) pmax = fmaxf(pmax, p1[r]);
    { auto rr = __builtin_amdgcn_permlane32_swap(__float_as_uint(pmax), __float_as_uint(pmax), false, false);
      pmax = fmaxf(__uint_as_float(rr[0]), __uint_as_float(rr[1])); }
    constexpr float C2 = 1.4426950408889634f * SCALE;
    if (__builtin_expect(__all((pmax - m_reg) * SCALE <= THR), 1)) { mn = m_reg; alpha = 1.f; }
    else { mn = fmaxf(m_reg, pmax); alpha = __builtin_amdgcn_exp2f((m_reg - mn) * C2); m_reg = mn; }
    const float mnL = -mn * C2;
    for (int r = 0; r < 16; ++r) p0[r] = fmaf(p0[r], C2, mnL); for (int r = 0; r < 16; ++r) p1[r] = fmaf(p1[r], C2, mnL);
    for (int r = 0; r < 16; ++r) p0[r] = __builtin_amdgcn_exp2f(p0[r]);
}
__device__ __forceinline__ void finishSM(f32x16& p0, f32x16& p1, float alpha, float& l_reg, bf16x8& pa0, bf16x8& pa1, bf16x8& pa2, bf16x8& pa3) {
    for (int r = 0; r < 16; ++r) p1[r] = __builtin_amdgcn_exp2f(p1[r]);
    float ps = 0; for (int r = 0; r < 16; ++r) ps += p0[r]; for (int r = 0; r < 16; ++r) ps += p1[r];
    { auto rr = __builtin_amdgcn_permlane32_swap(__float_as_uint(ps), __float_as_uint(ps), false, false);
      ps = __uint_as_float(rr[0]) + __uint_as_float(rr[1]); }
    l_reg = l_reg * alpha + ps;
#define PK4(P, B_, OUT) do { unsigned a0 = cvtpk(P[B_+0], P[B_+1]), a1 = cvtpk(P[B_+2], P[B_+3]);                          \
        unsigned b0 = cvtpk(P[B_+4], P[B_+5]), b1 = cvtpk(P[B_+6], P[B_+7]);                                             \
        auto r0 = __builtin_amdgcn_permlane32_swap(a0, b0, false, false); auto r1 = __builtin_amdgcn_permlane32_swap(a1, b1, false, false); \
        u32x4 w = {r0[0], r1[0], r0[1], r1[1]}; OUT = *reinterpret_cast<bf16x8*>(&w); } while (0)
    PK4(p0, 0, pa0); PK4(p0, 8, pa1); PK4(p1, 0, pa2); PK4(p1, 8, pa3);
#undef PK4
}
template <int KB, bool SK>
__device__ __forceinline__ void qkt(f32x16& p0, f32x16& p1, const char* K_lds, int r32, int hi, const bf16x8* qr, bool act) {
    if (SK && !act) { const float NEG = -__builtin_inff();
#pragma unroll
        for (int r = 0; r < 16; ++r) { p0[r] = NEG; p1[r] = NEG; } return; }
    { const f32x4* bb_ = (const f32x4*)(K_lds + 2 * SHM_K + NW * 64 * 4 + KB * 256) + hi;
#pragma unroll
        for (int g_ = 0; g_ < 4; ++g_) { const f32x4 b0_ = bb_[2 * g_], b1_ = bb_[8 + 2 * g_];
#pragma unroll
            for (int e_ = 0; e_ < 4; ++e_) { p0[4 * g_ + e_] = b0_[e_]; p1[4 * g_ + e_] = b1_[e_]; } } }
    const char* kb[4];
#pragma unroll
    for (int dd = 0; dd < 4; ++dd) kb[dd] = K_lds + KB * SHM_K + KSWZ(r32, (dd * 16 + hi * 8) * 2);
#pragma unroll
    for (int d0 = 0; d0 < 8; ++d0) { const char* a = kb[d0 & 3] + (d0 >> 2) * 128;
        bf16x8 b0 = *reinterpret_cast<const bf16x8*>(a);
        bf16x8 b1 = *reinterpret_cast<const bf16x8*>(a + 32 * 256);
        p0 = __builtin_amdgcn_mfma_f32_32x32x16_bf16(b0, qr[d0], p0, 0, 0, 0);
        p1 = __builtin_amdgcn_mfma_f32_32x32x16_bf16(b1, qr[d0], p1, 0, 0, 0); }
}
template <int VB, bool SK>
__device__ __forceinline__ void pv_tile(f32x16* o, int vb0, bf16x8 pa0, bf16x8 pa1, bf16x8 pa2, bf16x8 pa3, bool act) {
    if (SK && !act) return;
#define TRRD(dst, off) asm volatile("ds_read_b64_tr_b16 %0, %1 offset:%2" : "=&v"(dst) : "v"(vb0), "i"(off) : "memory")
#define PV_D0(d0) do { s16x4 l0, l1, l2, l3, h0, h1, h2, h3; constexpr int b_ = VB * SHM_V + v_rd_off(d0, 0, 0);     \
        TRRD(l0, b_); TRRD(h0, b_ + 2048); TRRD(l1, b_ + 4096); TRRD(h1, b_ + 6144); TRRD(l2, b_ + 8192); TRRD(h2, b_ + 10240); TRRD(l3, b_ + 12288); TRRD(h3, b_ + 14336); \
        asm volatile("s_waitcnt lgkmcnt(0)" ::: "memory"); SBAR();                 \
        o[d0] = __builtin_amdgcn_mfma_f32_32x32x16_bf16(pa0, (bf16x8){l0[0], l0[1], l0[2], l0[3], h0[0], h0[1], h0[2], h0[3]}, o[d0], 0, 0, 0);   \
        o[d0] = __builtin_amdgcn_mfma_f32_32x32x16_bf16(pa1, (bf16x8){l1[0], l1[1], l1[2], l1[3], h1[0], h1[1], h1[2], h1[3]}, o[d0], 0, 0, 0);   \
        o[d0] = __builtin_amdgcn_mfma_f32_32x32x16_bf16(pa2, (bf16x8){l2[0], l2[1], l2[2], l2[3], h2[0], h2[1], h2[2], h2[3]}, o[d0], 0, 0, 0);   \
        o[d0] = __builtin_amdgcn_mfma_f32_32x32x16_bf16(pa3, (bf16x8){l3[0], l3[1], l3[2], l3[3], h3[0], h3[1], h3[2], h3[3]}, o[d0], 0, 0, 0); } while (0)
    PV_D0(0); PV_D0(1); PV_D0(2); PV_D0(3);
#undef PV_D0
#undef TRRD
}

template <class TIn, class TOut> struct BlockRef { const TIn* Q; const TIn* K; const TIn* V; TOut* O; const float* F; float fref; int P0; int jlo, jhi; float* st; };
template <class TIn> struct Seam {
    bf16x8 qr[8];
    bf16x8 st_v0, st_v1, st_k0, st_k1; float st_f; f32x4 sf0, sf1, sf2, sf3;
    f32x4 tq[16];
};
__device__ __forceinline__ int swa_jlo(int P0, int W) { const int lowk = P0 - W + 1; return lowk > 0 ? lowk / KVBLK : 0; }
#define ROW(p, k0, rr) ((decltype(p))((const char*)(p) + (unsigned)((((k0) + (rr)) * D + sc) * (int)sizeof(*(p)))))
#define VMW() asm volatile("s_waitcnt vmcnt(0)" ::: "memory")
#define VMWN(n) asm volatile("s_waitcnt vmcnt(%0)" :: "i"(n) : "memory")
#define SLOAD_H(Kp, Vp, Fp, k0) do { S.st_v0 = load8<TIn>(ROW(Vp, k0, sr)); S.st_v1 = load8<TIn>(ROW(Vp, k0, 32 + sr));              \
                         S.st_k0 = load8<TIn>(ROW(Kp, k0, sr)); S.st_k1 = load8<TIn>(ROW(Kp, k0, 32 + sr)); if (tid < 64) S.st_f = (Fp)[(k0) + tid]; } while (0)
#define SWRITE_HK(bf, fr_) do { *(bf16x8*)(K_lds + (bf) * SHM_K + kws) = S.st_k0; *(bf16x8*)(K_lds + (bf) * SHM_K + kws + 32 * 256) = S.st_k1; \
        if (tid < 64) *(float*)(B_lds + (bf) * 256 + tid * 4) = ((fr_) - S.st_f) * RSCALE; } while (0)
#define SWRITE_HV(bf) do { *(bf16x8*)(V_lds + (bf) * SHM_V + vst0) = S.st_v0; *(bf16x8*)(V_lds + (bf) * SHM_V + vst1) = S.st_v1; } while (0)
#define SWRITE_H(bf) do { SWRITE_HV(bf); SWRITE_HK(bf, cur.fref); } while (0)
#define SLOAD_F(p, k0) do { S.sf0 = *(const f32x4*)ROW(p, k0, sr); S.sf1 = *(const f32x4*)(ROW(p, k0, sr) + 4);                \
                            S.sf2 = *(const f32x4*)ROW(p, k0, 32 + sr); S.sf3 = *(const f32x4*)(ROW(p, k0, 32 + sr) + 4); } while (0)
#define SWRITE_KF(bf) do { *(bf16x8*)(K_lds + (bf) * SHM_K + kws) = pack8(S.sf0, S.sf1); *(bf16x8*)(K_lds + (bf) * SHM_K + kws + 32 * 256) = pack8(S.sf2, S.sf3); } while (0)
#define SWRITE_VF(bf) do { *(bf16x8*)(V_lds + (bf) * SHM_V + vst0) = pack8(S.sf0, S.sf1); *(bf16x8*)(V_lds + (bf) * SHM_V + vst1) = pack8(S.sf2, S.sf3); } while (0)
template <class TIn, class TOut>
__device__ __forceinline__ void causal_swa_prime(const BlockRef<TIn, TOut>& cur, int W, char* lds, Seam<TIn>& S) {
    constexpr bool F32 = same_t<TIn, float>::v;
    const int tid = opaque_tid(), wid = __builtin_amdgcn_readfirstlane(tid >> 6), lane = tid & 63, r32 = lane & 31, hi = lane >> 5;
    const int sr = tid >> 4, sc = (tid & 15) * 8, kws = KSWZ(sr, sc * 2); char* K_lds = lds + 2 * SHM_V; char* B_lds = lds + LDS_BIAS;
    const int kb0 = (cur.jhi - 1) * KVBLK;
    for (int d0 = 0; d0 < 8; ++d0) S.qr[d0] = load8<TIn>(cur.Q + (size_t)(wid * QBLK + r32) * D + d0 * 16 + hi * 8);
    if constexpr (F32) { SLOAD_F((const float*)cur.K, kb0); VMW(); SWRITE_KF(0); SBAR(); SLOAD_F((const float*)cur.V, kb0); }
    else { SLOAD_H(cur.K, cur.V, cur.F, kb0); VMW(); SWRITE_HK(0, cur.fref); }
    __syncthreads();
}
template <class TIn, class TOut>
__device__ __forceinline__ void causal_swa_block(const BlockRef<TIn, TOut>& cur, const BlockRef<TIn, TOut>& nxt, int skv, int W, char* lds, Seam<TIn>& S) {
    constexpr bool F32 = same_t<TIn, float>::v;
    const int tid = opaque_tid(), wid = __builtin_amdgcn_readfirstlane(tid >> 6), lane = tid & 63, r32 = lane & 31, hi = lane >> 5;
    const int j_lo = cur.jlo;
    const int j_hi = cur.jhi;
    const int NT = j_hi - j_lo;
    const int kbn = (nxt.jhi - 1) * KVBLK;
    const int qlo = cur.P0 + wid * QBLK, qm = qlo + r32 - 4 * hi;
    char* V_lds = lds; char* K_lds = lds + 2 * SHM_V; char* B_lds = lds + LDS_BIAS;
    float* ws = (float*)(lds + 2 * SHM_V + 2 * SHM_K) + wid * 64; float* li_l = ws, * al_l = ws + 32;
    float m_reg = -1e30f, l_reg = 0; f32x16 o[4] = {};
    const int sr = tid >> 4, sc = (tid & 15) * 8, vst0 = v_st(sr, sc), vst1 = v_st(32 + sr, sc), kws = KSWZ(sr, sc * 2);
    const int vb0 = (int)(uintptr_t)V_lds + v_rd_base(lane);
    const TIn* Kh = cur.K; const TIn* Vh = cur.V; const float* Fh = cur.F;
#define RESC(a) do { if (__any((a) < 1.f)) { if (hi == 0) al_l[r32] = (a); asm volatile("s_waitcnt lgkmcnt(0)" ::: "memory");              \
                     for (int d_ = 0; d_ < 4; ++d_) for (int r = 0; r < 16; ++r) o[d_][r] *= al_l[crow(r, hi)]; } } while (0)
#define KBASE(t) ((j_hi - 1 - (t)) * KVBLK)
#define ACT(t) (KBASE(t) <= qlo + QBLK - 1 && KBASE(t) + KVBLK - 1 >= qlo - W + 1)
#define MASKT(P0_, P1_, t) do { const int kb_ = KBASE(t); if ((!SK || ACT(t)) && (kb_ + KVBLK - 1 > qlo || kb_ <= qlo + QBLK - 1 - W)) mask_tile(P0_, P1_, qm - kb_, (unsigned)W); } while (0)
#define ADD_BIAS(P0_, P1_, KB_) do { } while (0)
    constexpr int NQL = F32 ? 16 : 8;
    constexpr bool SK = WSKIP && !F32;
#define SEAM_K0() do { VMWN(NQL); if constexpr (F32) { SWRITE_KF(0); SBAR(); SLOAD_F((const float*)nxt.V, kbn); } else { SWRITE_HK(0, nxt.fref); } SBAR(); } while (0)
    f32x16 pA0, pA1, pB0, pB1; float mnA, mnB, alA, alB; bf16x8 pa0, pa1, pa2, pa3;
    if constexpr (F32) { VMW(); SWRITE_VF(0); SBAR(); } else { SWRITE_HV(0); SBAR(); }
    if (NT > 1) { if constexpr (F32) SLOAD_F((const float*)Kh, KBASE(1)); else SLOAD_H(Kh, Vh, Fh, KBASE(1)); }
    SBAR(); qkt<0, SK>(pA0, pA1, K_lds, r32, hi, S.qr, ACT(0));
    if constexpr (F32) { if (NT > 1) { VMW(); SWRITE_KF(1); SBAR(); SLOAD_F((const float*)Vh, KBASE(1)); } }
    ADD_BIAS(pA0, pA1, 0); MASKT(pA0, pA1, 0); partialSM(pA0, pA1, m_reg, mnA, alA);
    if (NT > 1) { VMW(); if constexpr (F32) { SWRITE_VF(1); SBAR(); if (NT > 2) SLOAD_F((const float*)Kh, KBASE(2)); } else SWRITE_H(1); }
    __syncthreads();
#define HALF_STEP(PX0, PX1, mnX, alX, PY0, PY1, alY, t, KB, VB, SB) do {                                                      \
        SBAR(); qkt<KB, SK>(PX0, PX1, K_lds, r32, hi, S.qr, ACT(t));                                             \
        finishSM(PY0, PY1, alY, l_reg, pa0, pa1, pa2, pa3); SBAR();                                                           \
        if ((t) + 1 < NT) { if constexpr (F32) { VMW(); SWRITE_KF(SB); SBAR(); SLOAD_F((const float*)Vh, KBASE((t) + 1)); }  \
                            else { SLOAD_H(Kh, Vh, Fh, KBASE((t) + 1)); } SBAR(); }                                               \
        pv_tile<VB, SK>(o, vb0, pa0, pa1, pa2, pa3, ACT((t) - 1)); ADD_BIAS(PX0, PX1, KB); MASKT(PX0, PX1, (t)); partialSM(PX0, PX1, m_reg, mnX, alX);                                        \
        __syncthreads();                                                                                                      \
        if ((t) + 1 < NT) { VMW(); if constexpr (F32) { SWRITE_VF(SB); SBAR(); if ((t) + 2 < NT) SLOAD_F((const float*)Kh, KBASE((t) + 2)); } \
                            else { SWRITE_H(SB); } }                                                                          \
        RESC(alX); __syncthreads(); } while (0)
    for (int t = 1; t + 1 < NT; t += 2) {
        HALF_STEP(pB0, pB1, mnB, alB, pA0, pA1, alA, t, 1, 0, 0);
        HALF_STEP(pA0, pA1, mnA, alA, pB0, pB1, alB, t + 1, 0, 1, 1);
    }
    const bool even = (NT & 1) == 0;
    if (even) { SBAR(); qkt<1, SK>(pB0, pB1, K_lds, r32, hi, S.qr, ACT(NT - 1)); SBAR(); }
#define QROW(e) (nxt.Q + (size_t)(wid * QBLK + r32) * D + ((e) >> 1) * 16 + hi * 8 + ((e) & 1) * 4)
    if constexpr (F32) { SLOAD_F((const float*)nxt.K, kbn); SBAR();
#pragma unroll
        for (int e = 0; e < 8; ++e) S.tq[e] = *(const f32x4*)QROW(e); }
    else { const TIn* nK_ = nxt.K; const TIn* nV_ = nxt.V; const float* nF_ = nxt.F; const TIn* nQ_ = nxt.Q; asm volatile("" : "+s"(nK_), "+s"(nV_), "+s"(nF_), "+s"(nQ_));
      SLOAD_H(nK_, nV_, nF_, kbn); SBAR();
#pragma unroll
        for (int d0 = 0; d0 < 8; ++d0) S.qr[d0] = load8<TIn>(nQ_ + (size_t)(wid * QBLK + r32) * D + d0 * 16 + hi * 8); }
    SBAR();
    finishSM(pA0, pA1, alA, l_reg, pa0, pa1, pa2, pa3); SBAR();
    if constexpr (F32) {
#pragma unroll
        for (int e = 8; e < 16; ++e) S.tq[e] = *(const f32x4*)QROW(e); SBAR(); }
#undef QROW
    pv_tile<0, SK>(o, vb0, pa0, pa1, pa2, pa3, ACT(even ? NT - 2 : NT - 1));
    if (even) { ADD_BIAS(pB0, pB1, 1); MASKT(pB0, pB1, NT - 1); partialSM(pB0, pB1, m_reg, mnB, alB); __syncthreads(); RESC(alB);
        finishSM(pB0, pB1, alB, l_reg, pa0, pa1, pa2, pa3); SBAR(); pv_tile<1, SK>(o, vb0, pa0, pa1, pa2, pa3, ACT(NT - 1)); }
    SBAR(); SEAM_K0();
    if (cur.st != nullptr) {
        float* sp_ = cur.st; asm volatile("" : "+s"(sp_)); sp_ += (size_t)(wid * 64) * 68 + lane * 4;
#pragma unroll
        for (int d0 = 0; d0 < 4; ++d0)
#pragma unroll
            for (int q4 = 0; q4 < 4; ++q4) *(f32x4*)(sp_ + (d0 * 4 + q4) * 256) = (f32x4){o[d0][q4 * 4], o[d0][q4 * 4 + 1], o[d0][q4 * 4 + 2], o[d0][q4 * 4 + 3]};
        *(f32x4*)(sp_ + 16 * 256) = (f32x4){m_reg, l_reg, 0.f, 0.f};
    } else {
    if (hi == 0) li_l[r32] = l_reg; asm volatile("s_waitcnt lgkmcnt(0)" ::: "memory");
    float rli[16];
#pragma unroll
    for (int r = 0; r < 16; ++r) rli[r] = __builtin_amdgcn_rcpf(li_l[crow(r, hi)]);
    TOut* Ob_ = cur.O; asm volatile("" : "+s"(Ob_)); TOut* Ow = Ob_ + (size_t)(wid * QBLK) * LDO;
    if constexpr (same_t<TOut, float>::v) {
#pragma unroll
        for (int r = 0; r < 16; ++r) { const int orow = crow(r, hi);
#pragma unroll
            for (int d0 = 0; d0 < 4; ++d0) Ow[(size_t)orow * LDO + d0 * 32 + r32] = o[d0][r] * rli[r]; }
    } else {
        char* stg = lds + LDS_OSTG + wid * 4352;
#pragma unroll
        for (int rd = 0; rd < 2; ++rd) {
#pragma unroll
            for (int r8 = 0; r8 < 8; ++r8) { const int r = rd * 8 + r8, lrow = (r8 & 3) + 8 * (r8 >> 2) + 4 * hi;
#pragma unroll
                for (int d0 = 0; d0 < 4; ++d0) { const float v = o[d0][r] * rli[r];
                    const float vn = __builtin_bit_cast(float, __builtin_amdgcn_mov_dpp(__builtin_bit_cast(int, v), 0xB1, 0xF, 0xF, true));
                    if ((r32 & 1) == 0) *(unsigned*)(stg + lrow * 272 + (d0 * 32 + r32) * 2) = cvtpk(v, vn); } }
            asm volatile("s_waitcnt lgkmcnt(0)" ::: "memory");
            uint4_t t4[4];
#pragma unroll
            for (int jj = 0; jj < 4; ++jj) t4[jj] = *(const uint4_t*)(stg + ((lane >> 4) + 4 * jj) * 272 + (lane & 15) * 16);
            asm volatile("s_waitcnt lgkmcnt(0)" ::: "memory");
#pragma unroll
            for (int jj = 0; jj < 4; ++jj) *(uint4_t*)(Ow + (size_t)(rd * 16 + (lane >> 4) + 4 * jj) * LDO + (lane & 15) * 8) = t4[jj];
        }
    }
    }
    if constexpr (F32) {
#pragma unroll
        for (int d0 = 0; d0 < 8; ++d0) S.qr[d0] = pack8(S.tq[2 * d0], S.tq[2 * d0 + 1]); }
    __syncthreads();
#undef RESC
#undef KBASE
#undef ACT
#undef MASKT
#undef ADD_BIAS
#undef SEAM_K0
#undef HALF_STEP
}
#undef ROW
#undef VMW
#undef VMWN
#undef SLOAD_H
#undef SWRITE_HK
#undef SWRITE_HV
#undef SWRITE_H
#undef SLOAD_F
#undef SWRITE_KF
#undef SWRITE_VF


}

#define LAS __attribute__((address_space(3)))
typedef unsigned u32x4 __attribute__((ext_vector_type(4)));
struct Params {
    const float *x_in, *c, *w_ada, *b_ada, *g_mix, *w_in, *b_f, *pool_w, *pool_scale, *lru_cw, *lru_cb, *lru_wa, *lru_ba, *lru_wi, *lru_bi, *lru_lam, *w_out, *g_ffn,
                *w_gate, *w_up, *ffn_cw, *ffn_cb, *w_down, *final_g;
    float* out; unsigned char* ws;
};
constexpr size_t WS_SPT = WS_MOD + 512 * 1024;
constexpr size_t WS_CSA = WS_XC, WS_CSH = WS_XC + 1 * MiB;
constexpr int NTHR = 512, LDS_RING = 131072, LDS_MISC = LDS_RING + 320, LDS_TOTAL = 147456;
constexpr int CW_BAR = 4096;
constexpr int NPH = 2 + 8 * DEPTH;
#define WSP(T, off) ((T*)(P.ws + (off)))
constexpr int LDS_HALO = LDS_RING + 4096;
constexpr int LDS_PTAB = LDS_RING + 1024;
__device__ __forceinline__ const void* ldp(const LAS unsigned* tab, int i) {
    const unsigned lo = __builtin_amdgcn_readfirstlane(tab[2 * i]), hi = __builtin_amdgcn_readfirstlane(tab[2 * i + 1]);
    return (const void*)(const __attribute__((address_space(1))) char*)(((unsigned long long)hi << 32) | lo);
}
__device__ __forceinline__ void stp(LAS unsigned* tab, int i, const void* p) { tab[2 * i] = (unsigned)(unsigned long long)p; tab[2 * i + 1] = (unsigned)((unsigned long long)p >> 32); }
__device__ __forceinline__ void store_params(LAS unsigned* t, const Params& P) {
    stp(t, 0, P.x_in); stp(t, 1, P.c); stp(t, 2, P.w_ada); stp(t, 3, P.b_ada); stp(t, 4, P.g_mix); stp(t, 5, P.w_in); stp(t, 6, P.b_f); stp(t, 7, P.pool_w); stp(t, 8, P.pool_scale);
    stp(t, 9, P.lru_cw); stp(t, 10, P.lru_cb); stp(t, 11, P.lru_wa); stp(t, 12, P.lru_ba); stp(t, 13, P.lru_wi); stp(t, 14, P.lru_bi); stp(t, 15, P.lru_lam); stp(t, 16, P.w_out); stp(t, 17, P.g_ffn);
    stp(t, 18, P.w_gate); stp(t, 19, P.w_up); stp(t, 20, P.ffn_cw); stp(t, 21, P.ffn_cb); stp(t, 22, P.w_down); stp(t, 23, P.final_g); stp(t, 24, P.out); stp(t, 25, P.ws);
}
__device__ __forceinline__ Params load_params(const LAS unsigned* t) {
    Params P;
#define LDF(i) ((const float*)ldp(t, i))
    P.x_in = LDF(0); P.c = LDF(1); P.w_ada = LDF(2); P.b_ada = LDF(3); P.g_mix = LDF(4); P.w_in = LDF(5); P.b_f = LDF(6); P.pool_w = LDF(7); P.pool_scale = LDF(8);
    P.lru_cw = LDF(9); P.lru_cb = LDF(10); P.lru_wa = LDF(11); P.lru_ba = LDF(12); P.lru_wi = LDF(13); P.lru_bi = LDF(14); P.lru_lam = LDF(15); P.w_out = LDF(16); P.g_ffn = LDF(17);
    P.w_gate = LDF(18); P.w_up = LDF(19); P.ffn_cw = LDF(20); P.ffn_cb = LDF(21); P.w_down = LDF(22); P.final_g = LDF(23); P.out = (float*)ldp(t, 24); P.ws = (unsigned char*)ldp(t, 25);
#undef LDF
    return P;
}

__device__ __forceinline__ unsigned pk2bf(float lo, float hi) { typedef float f32x2_ __attribute__((ext_vector_type(2))); typedef __bf16 bf16x2_ __attribute__((ext_vector_type(2)));
    const f32x2_ v = {lo, hi}; return __builtin_bit_cast(unsigned, __builtin_convertvector(v, bf16x2_)); }
__device__ __forceinline__ float bflo(unsigned w) { return __uint_as_float(w << 16); }
__device__ __forceinline__ float bfhi(unsigned w) { return __uint_as_float(w & 0xffff0000u); }
#define UNPACK8(W_, F_) do { const u32x4 w_ = (W_); F_[0] = bflo(w_[0]); F_[1] = bfhi(w_[0]); F_[2] = bflo(w_[1]); F_[3] = bfhi(w_[1]); F_[4] = bflo(w_[2]); F_[5] = bfhi(w_[2]); F_[6] = bflo(w_[3]); F_[7] = bfhi(w_[3]); } while (0)
#define PACK8(F_) ((u32x4){pk2bf(F_[0], F_[1]), pk2bf(F_[2], F_[3]), pk2bf(F_[4], F_[5]), pk2bf(F_[6], F_[7])})

__device__ __forceinline__ float wave_sum(float v) {
    v += __builtin_bit_cast(float, __builtin_amdgcn_ds_swizzle(__builtin_bit_cast(int, v), 0x041f));
    v += __builtin_bit_cast(float, __builtin_amdgcn_ds_swizzle(__builtin_bit_cast(int, v), 0x081f));
    v += __builtin_bit_cast(float, __builtin_amdgcn_ds_swizzle(__builtin_bit_cast(int, v), 0x101f));
    v += __builtin_bit_cast(float, __builtin_amdgcn_ds_swizzle(__builtin_bit_cast(int, v), 0x201f));
    v += __builtin_bit_cast(float, __builtin_amdgcn_ds_swizzle(__builtin_bit_cast(int, v), 0x401f));
    const auto rr = __builtin_amdgcn_permlane32_swap(__float_as_uint(v), __float_as_uint(v), false, false);
    return __uint_as_float(rr[0]) + __uint_as_float(rr[1]);
}
__device__ __forceinline__ float fexp(float x) { return __builtin_amdgcn_exp2f(x * 1.4426950408889634f); }
__device__ __forceinline__ float fsigmoid(float x) { return __builtin_amdgcn_rcpf(1.f + fexp(-x)); }
__device__ __forceinline__ float fgelu_tanh(float x) { const float u = 0.7978845608028654f * (x + 0.044715f * x * x * x); return x * fsigmoid(2.f * u); }
__device__ __forceinline__ float one_minus_exp(float x) { return fabsf(x) < 2e-3f ? -x * (1.f + 0.5f * x * (1.f + x * (1.f / 3.f))) : 1.f - fexp(x); }
__device__ __forceinline__ void tr_item(const float* __restrict__ W, int ldw, int K, bf16_t* __restrict__ WT, int rstride, int roff, float* scr, int kb, int nb_, int lane) {
    const int k0 = 64 * kb, n0 = 32 * nb_;
#pragma unroll 8
    for (int i = 0; i < 32; ++i) { const int kk = 2 * i + (lane >> 5); scr[kk * 33 + (lane & 31)] = __builtin_nontemporal_load(W + (size_t)(k0 + kk) * ldw + n0 + (lane & 31)); }
    asm volatile("s_waitcnt lgkmcnt(0)" ::: "memory");
    const int c = lane & 7, rbase = (n0 >> 7) * rstride + (n0 & 127) + roff;
#pragma unroll
    for (int j = 0; j < 4; ++j) { const int n = (lane >> 3) + 8 * j; const float* s = scr + (8 * c) * 33 + n;
        u32x4 o; o.x = pk2bf(s[0 * 33], s[1 * 33]); o.y = pk2bf(s[2 * 33], s[3 * 33]); o.z = pk2bf(s[4 * 33], s[5 * 33]); o.w = pk2bf(s[6 * 33], s[7 * 33]);
        *(u32x4*)(WT + (size_t)(rbase + n) * K + k0 + 8 * c) = o; }
    asm volatile("s_waitcnt lgkmcnt(0)" ::: "memory");
}
__device__ __forceinline__ void tr_kind(const float* W, int ldw, size_t src_z, int K, int N, int nz, bf16_t* WT, int rstride, int roff, size_t dst_z, float* scr, int gw, int ngw, int lane) {
    const int nblk = N / 32, per = (K / 64) * nblk, total = per * nz;
    for (int it = gw; it < total; it += ngw) { const int z = it / per, r = it - z * per;
        tr_item(W + (size_t)z * src_z, ldw, K, WT + (size_t)z * dst_z, rstride, roff, scr, r / nblk, r % nblk, lane); }
}
__device__ __forceinline__ void ada_layer(const Params& P, char* lds, int l, int rank, int nranks) {
    const int tid = opaque_tid(), lane = tid & 63, wave = tid >> 6;
    float* cact = (float*)lds; float* red = cact + 2 * DM; float* mod = WSP(float, WS_MOD);
    for (int i = tid; i < 2 * DM; i += NTHR) { const float cv = P.c[i]; cact[i] = cv / (1.f + expf(-cv)); }
    __syncthreads();
    for (int it = rank; it < NADA / 64; it += nranks) {
        const int j = it * 64 + lane;
        const float* w = P.w_ada + ((size_t)l * DM + wave * 256) * NADA + j; const float* c0 = cact + wave * 256; const float* c1 = c0 + DM;
        float s0 = 0.f, s1 = 0.f;
#pragma unroll 32
        for (int kk = 0; kk < 256; ++kk) { const float wv = __builtin_nontemporal_load(w + (size_t)kk * NADA); s0 += c0[kk] * wv; s1 += c1[kk] * wv; }
        red[(wave * 64 + lane) * 2 + 0] = s0; red[(wave * 64 + lane) * 2 + 1] = s1;
        __syncthreads();
        if (tid < 128) { const int jj = tid & 63, b = tid >> 6, jc = it * 64 + jj; float s = P.b_ada[l * NADA + jc];
#pragma unroll
            for (int ks = 0; ks < 8; ++ks) s += red[(ks * 64 + jj) * 2 + b];
            mod[((size_t)l * 2 + b) * NADA + jc] = s; }
        __syncthreads();
    }
}
__device__ __forceinline__ void ph_prologue(const Params& P, char* lds, int bid, int nb) {
    const int tid = opaque_tid(), lane = tid & 63, wave = tid >> 6;
    if (bid == 0) for (int i = tid; i < DEPTH * LW; i += NTHR) WSP(float, WS_SPT)[i] = log1pf(expf(-P.lru_lam[i]));
    ada_layer(P, lds, 0, bid, nb);
    __syncthreads();
    float* scr = (float*)(lds + wave * 16384); const int gw = bid * 8 + wave, ngw = nb * 8;
    tr_kind(P.w_gate, DFF, (size_t)DM * DFF, DM, DFF, DEPTH, WSP(bf16_t, WS_WGU), 256, 0, (size_t)NGU * DM, scr, gw, ngw, lane);
    tr_kind(P.w_up, DFF, (size_t)DM * DFF, DM, DFF, DEPTH, WSP(bf16_t, WS_WGU), 256, 128, (size_t)NGU * DM, scr, gw, ngw, lane);
    tr_kind(P.w_down, DM, (size_t)DFF * DM, DFF, DM, DEPTH, WSP(bf16_t, WS_WDN), 128, 0, (size_t)DM * DFF, scr, gw, ngw, lane);
    tr_kind(P.w_in, NIN, (size_t)DM * NIN, DM, 3584, DEPTH, WSP(bf16_t, WS_WIN), 128, 0, (size_t)NZ * DM, scr, gw, ngw, lane);
    tr_kind(P.w_in + 3592, NIN, (size_t)DM * NIN, DM, 1024, DEPTH, WSP(bf16_t, WS_WIN), 128, 3584, (size_t)NZ * DM, scr, gw, ngw, lane);
    tr_kind(P.w_out, DM, (size_t)DM * DM, DM, DM, DEPTH, WSP(bf16_t, WS_WOUT), 128, 0, (size_t)DM * DM, scr, gw, ngw, lane);
    tr_kind(P.pool_w, 128, 16384, 128, 128, 4 * DEPTH, WSP(bf16_t, WS_WSM), 128, 0, 16384, scr, gw, ngw, lane);
    tr_kind(P.lru_wa, 128, 16384, 128, 128, 4 * DEPTH, WSP(bf16_t, WS_WSM) + 16 * 16384, 128, 0, 16384, scr, gw, ngw, lane);
    tr_kind(P.lru_wi, 128, 16384, 128, 128, 4 * DEPTH, WSP(bf16_t, WS_WSM) + 32 * 16384, 128, 0, 16384, scr, gw, ngw, lane);
}

using pg8::h16x8;
constexpr size_t WS_XH = 1100 * MiB;
template <int WHICH, bool XF32>
__device__ __forceinline__ void ph_norm(const Params& P, char* lds, int l, int bid, int nb) {
    const int tid = opaque_tid(), lane = tid & 63, wave = tid >> 6;
    const float* x = P.x_in; const _Float16* xh = WSP(const _Float16, WS_XH);
    const float* g = (WHICH ? P.g_ffn : P.g_mix) + l * DM; const float* modl = WSP(float, WS_MOD) + (size_t)l * 2 * NADA + (WHICH ? 3 * DM : 0);
    bf16_t* H = WSP(bf16_t, WS_H); float* FL = WSP(float, WS_FL);
    float* wft = (float*)lds;
    if (WHICH == 0) { const float* wf = P.w_in + (size_t)l * DM * NIN + 3584;
        for (int k = tid; k < DM; k += NTHR) { const f32x4 w0 = *(const f32x4*)(wf + (size_t)k * NIN), w1 = *(const f32x4*)(wf + (size_t)k * NIN + 4);
#pragma unroll
            for (int f = 0; f < 4; ++f) { wft[f * DM + k] = w0[f]; wft[(4 + f) * DM + k] = w1[f]; } }
        __syncthreads(); }
    for (int row = (bid * 8 + wave) * 2; row < M; row += nb * 16) {
        const float* xr = x + (size_t)row * DM; const _Float16* xhr = xh + (size_t)row * DM; const float* sh = modl + (row >> 13) * NADA; const float* sc = sh + DM;
        f32x4 v0[8], v1[8]; float ss0 = 0.f, ss1 = 0.f;
        if constexpr (XF32) {
#pragma unroll
            for (int j = 0; j < 8; ++j) { v0[j] = *(const f32x4*)(xr + j * 256 + lane * 4); v1[j] = *(const f32x4*)(xr + DM + j * 256 + lane * 4); }
            _Float16* xw = WSP(_Float16, WS_XH) + (size_t)row * DM;
#pragma unroll
            for (int j = 0; j < 8; ++j) { *(pg8::h16x4*)(xw + j * 256 + lane * 4) = __builtin_convertvector(v0[j], pg8::h16x4); *(pg8::h16x4*)(xw + DM + j * 256 + lane * 4) = __builtin_convertvector(v1[j], pg8::h16x4); }
        } else { pg8::h16x4 t0[8], t1[8];
#pragma unroll
            for (int j = 0; j < 8; ++j) { t0[j] = *(const pg8::h16x4*)(xhr + j * 256 + lane * 4); t1[j] = *(const pg8::h16x4*)(xhr + DM + j * 256 + lane * 4); }
#pragma unroll
            for (int j = 0; j < 8; ++j) { v0[j] = __builtin_convertvector(t0[j], f32x4); v1[j] = __builtin_convertvector(t1[j], f32x4); } }
#pragma unroll
        for (int j = 0; j < 8; ++j) { ss0 += v0[j][0] * v0[j][0] + v0[j][1] * v0[j][1] + v0[j][2] * v0[j][2] + v0[j][3] * v0[j][3];
                                      ss1 += v1[j][0] * v1[j][0] + v1[j][1] * v1[j][1] + v1[j][2] * v1[j][2] + v1[j][3] * v1[j][3]; }
        ss0 = wave_sum(ss0); ss1 = wave_sum(ss1);
        const float r0 = rsqrtf(ss0 * (1.f / DM) + 1e-6f), r1 = rsqrtf(ss1 * (1.f / DM) + 1e-6f);
        float fa0[8] = {0.f, 0.f, 0.f, 0.f, 0.f, 0.f, 0.f, 0.f}, fa1[8] = {0.f, 0.f, 0.f, 0.f, 0.f, 0.f, 0.f, 0.f};
#pragma unroll
        for (int j = 0; j < 8; ++j) {
            const int i0 = j * 256 + lane * 4; const f32x4 gg = *(const f32x4*)(g + i0), s1 = *(const f32x4*)(sc + i0), s0 = *(const f32x4*)(sh + i0);
            const f32x4 ga = gg * (s1 + 1.f); const f32x4 h0 = v0[j] * r0 * ga + s0, h1 = v1[j] * r1 * ga + s0;
            *(uint2*)(H + (size_t)row * DM + i0) = (uint2){pk2bf(h0[0], h0[1]), pk2bf(h0[2], h0[3])};
            *(uint2*)(H + (size_t)(row + 1) * DM + i0) = (uint2){pk2bf(h1[0], h1[1]), pk2bf(h1[2], h1[3])};
            if (WHICH == 0) {
#pragma unroll
                for (int f = 0; f < 8; ++f) { const f32x4 wv = *(const f32x4*)(wft + f * DM + i0);
                    fa0[f] += h0[0] * wv[0] + h0[1] * wv[1] + h0[2] * wv[2] + h0[3] * wv[3]; fa1[f] += h1[0] * wv[0] + h1[1] * wv[1] + h1[2] * wv[2] + h1[3] * wv[3]; }
            }
            if ((j & 3) == 3) asm volatile("" ::: "memory");
        }
        if (WHICH == 0) {
#pragma unroll
            for (int f = 0; f < 8; ++f) { fa0[f] = wave_sum(fa0[f]); fa1[f] = wave_sum(fa1[f]); }
            { float fv = fa0[0];
#pragma unroll
                for (int f = 1; f < 8; ++f) fv = (lane == f) ? fa0[f] : fv;
#pragma unroll
                for (int f = 0; f < 8; ++f) fv = (lane == 8 + f) ? fa1[f] : fv;
                const float lf = log_sigmoidf_(fv + P.b_f[l * 8 + (lane & 7)]);
                if (lane < 16) FL[((size_t)(row >> 13) * 8 + (lane & 7)) * SEQ + ((row + (lane >> 3)) & (SEQ - 1))] = lf; }
        }
    }
}

constexpr int MP_ZP = 0, MP_ZX = 20480, MP_AT = 0, MP_ABP = 38912, MP_ABX = 56320, MP_XC = 73728, MP_YT = 107520;
__device__ __forceinline__ void small_gemm(const char* atile, const bf16_t* __restrict__ Bt, int wave, int fr, int fq, f32x4 (&acc)[4]) {
    const char* ap = atile + ((wave & 3) * 16 + fr) * 272 + fq * 16; const bf16_t* bp = Bt + (size_t)((wave >> 2) * 64 + fr) * 128 + fq * 8;
#pragma unroll
    for (int j = 0; j < 4; ++j) acc[j] = (f32x4){0.f, 0.f, 0.f, 0.f};
#pragma unroll
    for (int k4 = 0; k4 < 4; ++k4) { const bf16x8 a = *(const bf16x8*)(ap + k4 * 64);
#pragma unroll
        for (int j = 0; j < 4; ++j) { const bf16x8 b = *(const bf16x8*)(bp + (size_t)j * 16 * 128 + k4 * 32); acc[j] = __builtin_amdgcn_mfma_f32_16x16x32_bf16(a, b, acc[j], 0, 0, 0); } }
}
__device__ __forceinline__ void sg_loadb(const bf16_t* __restrict__ Bt, int wave, int fr, int fq, bf16x8 (&b)[16]) {
    const bf16_t* bp = Bt + (size_t)((wave >> 2) * 64 + fr) * 128 + fq * 8;
#pragma unroll
    for (int k4 = 0; k4 < 4; ++k4)
#pragma unroll
        for (int j = 0; j < 4; ++j) b[k4 * 4 + j] = *(const bf16x8*)(bp + (size_t)j * 16 * 128 + k4 * 32);
}
__device__ __forceinline__ void sg_mma(const char* atile, const bf16x8 (&b)[16], int wave, int fr, int fq, f32x4 (&acc)[4]) {
    const char* ap = atile + ((wave & 3) * 16 + fr) * 272 + fq * 16;
#pragma unroll
    for (int j = 0; j < 4; ++j) acc[j] = (f32x4){0.f, 0.f, 0.f, 0.f};
#pragma unroll
    for (int k4 = 0; k4 < 4; ++k4) { const bf16x8 a = *(const bf16x8*)(ap + k4 * 64);
#pragma unroll
        for (int j = 0; j < 4; ++j) acc[j] = __builtin_amdgcn_mfma_f32_16x16x32_bf16(a, b[k4 * 4 + j], acc[j], 0, 0, 0); }
}
__device__ __forceinline__ void mp_load(const Params& P, int rt, int j, int tid, u32x4 (&pre)[5]) {
    const int r0 = rt * 64, t0 = r0 & (SEQ - 1); const bf16_t* ZP = WSP(const bf16_t, WS_ZP); const bf16_t* ZX = WSP(const bf16_t, WS_ZX);
#pragma unroll
    for (int k = 0; k < 5; ++k) { const int ch = tid + NTHR * k; const bool isx = ch >= 79 * 16; const int cc = isx ? ch - 79 * 16 : ch, row = cc >> 4, c16 = cc & 15, back = isx ? 3 : 15;
        pre[k] = (u32x4){0u, 0u, 0u, 0u};
        if (ch < (79 + 67) * 16 && t0 - back + row >= 0) pre[k] = *(const u32x4*)((isx ? ZX : ZP) + (size_t)(r0 - back + row) * 512 + j * 128 + c16 * 8); }
}
__device__ __forceinline__ void mp_store(char* lds, int tid, const u32x4 (&pre)[5]) {
#pragma unroll
    for (int k = 0; k < 5; ++k) { const int ch = tid + NTHR * k; const bool isx = ch >= 79 * 16; const int cc = isx ? ch - 79 * 16 : ch, row = cc >> 4, c16 = cc & 15;
        if (ch < (79 + 67) * 16) *(u32x4*)(lds + (isx ? MP_ZX : MP_ZP) + row * 256 + c16 * 16) = pre[k]; }
}
__device__ __forceinline__ void mp_unit(const Params& P, char* lds, int l, int rt, int j, u32x4 (&pre)[5], int rt_next, int j_next) {
    const int tid = opaque_tid(), lane = tid & 63, wave = tid >> 6, fr = lane & 15, fq = lane >> 4;
    const int r0 = rt * 64, t0 = r0 & (SEQ - 1), win = 2 << j;
    bf16x8 bpool[16]; sg_loadb(WSP(const bf16_t, WS_WSM) + (size_t)(l * 4 + j) * 16384, wave, fr, fq, bpool);
    mp_store(lds, tid, pre);
    __syncthreads();
    { const int c8 = tid & 15, rg = tid >> 4, chn = j * 128 + c8 * 8;
        float cw[4][8], cb[8]; const float* cwp = P.lru_cw + (size_t)l * 4 * LW + chn; const float* cbp = P.lru_cb + l * LW + chn;
#pragma unroll
        for (int k = 0; k < 4; ++k) { const f32x4 a = *(const f32x4*)(cwp + k * LW), b = *(const f32x4*)(cwp + k * LW + 4);
#pragma unroll
            for (int e = 0; e < 4; ++e) { cw[k][e] = a[e]; cw[k][4 + e] = b[e]; } }
        { const f32x4 a = *(const f32x4*)cbp, b = *(const f32x4*)(cbp + 4);
#pragma unroll
            for (int e = 0; e < 4; ++e) { cb[e] = a[e]; cb[4 + e] = b[e]; } }
#pragma unroll
        for (int rr = 0; rr < 2; ++rr) { const int row = rg * 2 + rr, t = t0 + row; float s[8], u[8], xc[8];
            { const u32x4 z = *(const u32x4*)(lds + MP_ZP + (row + 15) * 256 + c8 * 16); UNPACK8(z, u); }
#pragma unroll
            for (int e = 0; e < 8; ++e) { s[e] = u[e]; xc[e] = cb[e]; }
            for (int q = 1; q < win; ++q) { const u32x4 z = *(const u32x4*)(lds + MP_ZP + (row + 15 - q) * 256 + c8 * 16); float zf[8]; UNPACK8(z, zf);
#pragma unroll
                for (int e = 0; e < 8; ++e) s[e] += zf[e]; }
            const float rn = __builtin_amdgcn_rcpf((float)((t + 1 < win) ? t + 1 : win)); float d[8];
#pragma unroll
            for (int e = 0; e < 8; ++e) d[e] = s[e] * rn - u[e];
            *(u32x4*)(lds + MP_ABP + row * 272 + c8 * 16) = PACK8(d);
#pragma unroll
            for (int k = 0; k < 4; ++k) { const u32x4 z = *(const u32x4*)(lds + MP_ZX + (row + k) * 256 + c8 * 16); float zf[8]; UNPACK8(z, zf);
#pragma unroll
                for (int e = 0; e < 8; ++e) xc[e] += cw[k][e] * zf[e]; }
            float* xo = (float*)(lds + MP_XC) + row * 132 + c8 * 8;
            *(f32x4*)xo = (f32x4){xc[0], xc[1], xc[2], xc[3]}; *(f32x4*)(xo + 4) = (f32x4){xc[4], xc[5], xc[6], xc[7]};
            *(u32x4*)(lds + MP_ABX + row * 272 + c8 * 16) = PACK8(xc); } }
    __syncthreads();
    if (rt_next >= 0) mp_load(P, rt_next, j_next, tid, pre);
    { const bf16_t* wsm = WSP(const bf16_t, WS_WSM);
        { f32x4 acc[4]; sg_mma(lds + MP_ABP, bpool, wave, fr, fq, acc);
#pragma unroll
            for (int q = 0; q < 4; ++q) { const int lc = (wave >> 2) * 64 + 16 * q + fr; const float sc = P.pool_scale[l * PW + j * 128 + lc];
#pragma unroll
                for (int e = 0; e < 4; ++e) { const int lr = (wave & 3) * 16 + fq * 4 + e; ((bf16_t*)(lds + MP_YT))[lr * 128 + lc] = (bf16_t)pk2bf(acc[q][e] * sc, 0.f); } } }
        f32x4 ga[4], gi[4];
        small_gemm(lds + MP_ABX, wsm + (size_t)(16 + l * 4 + j) * 16384, wave, fr, fq, ga);
        small_gemm(lds + MP_ABX, wsm + (size_t)(32 + l * 4 + j) * 16384, wave, fr, fq, gi);
#pragma unroll
        for (int q = 0; q < 4; ++q) { const int lc = (wave >> 2) * 64 + 16 * q + fr, chn = j * 128 + lc;
            const float ba = P.lru_ba[l * LW + chn], bi = P.lru_bi[l * LW + chn], sp = WSP(const float, WS_SPT)[l * LW + chn];
#pragma unroll
            for (int e = 0; e < 4; ++e) { const int lr = (wave & 3) * 16 + fq * 4 + e; float* xp = (float*)(lds + MP_XC) + lr * 132 + lc;
                const float gr = fsigmoid(ga[q][e] + ba), gin = fsigmoid(gi[q][e] + bi), la = -8.f * gr * sp;
                const float inp = __builtin_amdgcn_sqrtf(one_minus_exp(2.f * la)) * (gin * *xp);
                *xp = inp; ((float*)(lds + MP_AT))[lr * 132 + lc] = fexp(la); } } }
    __syncthreads();
    if (tid < 128) { float h = 0.f, p = 1.f; float* xc = (float*)(lds + MP_XC) + tid; float* at = (float*)(lds + MP_AT) + tid;
#pragma unroll 8
        for (int r = 0; r < 64; ++r) { const float a = at[r * 132]; h = a * h + xc[r * 132]; p *= a; xc[r * 132] = h; at[r * 132] = p; }
        const size_t so = ((size_t)(r0 >> 13) * 128 + (t0 >> 6)) * LW + j * 128 + tid;
        WSP(float, WS_CSA)[so] = p; WSP(float, WS_CSH)[so] = h; }
    else { bf16_t* Y = WSP(bf16_t, WS_Y);
        for (int idx = tid - 128; idx < 1024; idx += NTHR - 128) { const int row = idx >> 4, c16 = idx & 15;
            *(u32x4*)(Y + (size_t)(r0 + row) * DM + j * 128 + c16 * 8) = *(const u32x4*)(lds + MP_YT + row * 256 + c16 * 16); } }
    __syncthreads();
    { _Float16* HL = WSP(_Float16, WS_LRUA); _Float16* PC = WSP(_Float16, WS_LRUB);
#pragma unroll
        for (int idx = tid; idx < 1024; idx += NTHR) { const int row = idx >> 4, c8 = idx & 15; const size_t go = (size_t)(r0 + row) * LW + j * 128 + c8 * 8;
            const float* xs = (const float*)(lds + MP_XC) + row * 132 + c8 * 8; const float* as = (const float*)(lds + MP_AT) + row * 132 + c8 * 8;
            const pg8::h16x4 h0 = __builtin_convertvector(*(const f32x4*)xs, pg8::h16x4), h1 = __builtin_convertvector(*(const f32x4*)(xs + 4), pg8::h16x4);
            const pg8::h16x4 p0 = __builtin_convertvector(*(const f32x4*)as, pg8::h16x4), p1 = __builtin_convertvector(*(const f32x4*)(as + 4), pg8::h16x4);
            *(h16x8*)(HL + go) = __builtin_shufflevector(h0, h1, 0, 1, 2, 3, 4, 5, 6, 7); *(h16x8*)(PC + go) = __builtin_shufflevector(p0, p1, 0, 1, 2, 3, 4, 5, 6, 7); } }
    __syncthreads();
}
__device__ __forceinline__ void fscan_wave(const Params& P, char* lds, int bh) {
    const int tid_ = opaque_tid(), lane = tid_ & 63, wave = tid_ >> 6;
    const f32x4* src = (const f32x4*)(WSP(const float, WS_FL) + (size_t)bh * SEQ + lane * 128); f32x4* dst = (f32x4*)(WSP(float, WS_F) + (size_t)bh * SEQ + lane * 128);
    f32x4 v[32]; float tot = 0.f;
#pragma unroll
    for (int i = 0; i < 32; ++i) v[i] = src[i];
#pragma unroll
    for (int i = 0; i < 32; ++i) { v[i][0] += tot; v[i][1] += v[i][0]; v[i][2] += v[i][1]; v[i][3] += v[i][2]; tot = v[i][3]; }
    float* sc = (float*)lds + wave * 64; sc[lane] = tot;
    asm volatile("s_waitcnt lgkmcnt(0)" ::: "memory");
    float off = 0.f;
    for (int i = 0; i < 64; ++i) { const float t = sc[i]; off += (i < lane) ? t : 0.f; }
#pragma unroll
    for (int i = 0; i < 32; ++i) dst[i] = v[i] + off;
}
__device__ __forceinline__ void ph_mixprep(const Params& P, char* lds, int l, int bid, int nb) {
    if (bid >= 1024) return;
    const int rot = (nb & 3) == 0 ? 1 : 0; int k = 0;
    u32x4 pre[5]; mp_load(P, bid >> 2, bid & 3, opaque_tid(), pre);
    for (int u = bid; u < 1024; u += nb, k += rot) { const int un = u + nb;
        mp_unit(P, lds, l, u >> 2, ((u & 3) + k) & 3, pre, un < 1024 ? (un >> 2) : -1, ((un & 3) + k + rot) & 3); }
}
__device__ __forceinline__ void lru_fixup_tile(const Params& P, char* lds, int rt) {
    const int tid = opaque_tid(), r0 = rt * 64, b = r0 >> 13, chunk = (r0 & (SEQ - 1)) >> 6, hlf = chunk >> 1;
    float* carry = (float*)lds;
    { const float* ca = WSP(const float, WS_CSA) + (size_t)b * 128 * LW + tid; const float* chh = WSP(const float, WS_CSH) + (size_t)b * 128 * LW + tid;
        float s1 = 0.f, a2 = 1.f, s2 = 0.f;
#pragma unroll 16
        for (int i = 0; i < hlf; ++i) { const float x1 = ca[(size_t)i * LW], y1 = chh[(size_t)i * LW], x2 = ca[(size_t)(hlf + i) * LW], y2 = chh[(size_t)(hlf + i) * LW];
            s1 = x1 * s1 + y1; s2 = x2 * s2 + y2; a2 *= x2; }
        float cin = a2 * s1 + s2;
        if (chunk & 1) cin = ca[(size_t)(chunk - 1) * LW] * cin + chh[(size_t)(chunk - 1) * LW];
        carry[tid] = cin; }
    __syncthreads();
    const _Float16* HL = WSP(const _Float16, WS_LRUA); const _Float16* PC = WSP(const _Float16, WS_LRUB); const bf16_t* ZY = WSP(const bf16_t, WS_ZY); bf16_t* Y = WSP(bf16_t, WS_Y);
#pragma unroll 8
    for (int idx = tid; idx < 4096; idx += NTHR) { const int row = idx >> 6, c8 = idx & 63; const size_t off = (size_t)(r0 + row) * LW + c8 * 8;
        const h16x8 hh = *(const h16x8*)(HL + off), pp = *(const h16x8*)(PC + off);
        const f32x4 h0 = __builtin_convertvector(__builtin_shufflevector(hh, hh, 0, 1, 2, 3), f32x4), h1 = __builtin_convertvector(__builtin_shufflevector(hh, hh, 4, 5, 6, 7), f32x4);
        const f32x4 p0 = __builtin_convertvector(__builtin_shufflevector(pp, pp, 0, 1, 2, 3), f32x4), p1 = __builtin_convertvector(__builtin_shufflevector(pp, pp, 4, 5, 6, 7), f32x4);
        const f32x4 c0 = *(const f32x4*)(carry + c8 * 8), c1 = *(const f32x4*)(carry + c8 * 8 + 4); const u32x4 zy = *(const u32x4*)(ZY + off); float zf[8], y[8]; UNPACK8(zy, zf);
#pragma unroll
        for (int e = 0; e < 4; ++e) { y[e] = (h0[e] + p0[e] * c0[e]) * fgelu_tanh(zf[e]); y[4 + e] = (h1[e] + p1[e] * c1[e]) * fgelu_tanh(zf[4 + e]); }
        *(u32x4*)(Y + (size_t)(r0 + row) * DM + 1536 + c8 * 8) = PACK8(y); }
    __syncthreads();
}
constexpr size_t WS_SIDE = WS_SCR;
__device__ __forceinline__ void ffn_fix_tile(const Params& P, int l, int pm) {
    const float* side = WSP(const float, WS_SIDE) + (size_t)pm * 6 * DFF; bf16_t* ACT = WSP(bf16_t, WS_ACT) + (size_t)pm * 256 * DFF;
    const float* cwp = P.ffn_cw + (size_t)l * 3 * DFF; const float* cbp = P.ffn_cb + l * DFF; const bool first = (pm & 31) == 0;
    for (int i = opaque_tid(); i < DFF / 8; i += NTHR) { const int c = i * 8;
#pragma unroll
        for (int h = 0; h < 2; ++h) { const int cc = c + 4 * h;
            const f32x4 g0 = *(const f32x4*)(side + cc), g1 = *(const f32x4*)(side + DFF + cc), u0 = *(const f32x4*)(side + 2 * DFF + cc), u1 = *(const f32x4*)(side + 3 * DFF + cc);
            f32x4 gm2 = {0.f, 0.f, 0.f, 0.f}, gm1 = {0.f, 0.f, 0.f, 0.f};
            if (!first) { gm2 = *(const f32x4*)(side - 2 * DFF + cc); gm1 = *(const f32x4*)(side - DFF + cc); }
            const f32x4 w0 = *(const f32x4*)(cwp + cc), w1 = *(const f32x4*)(cwp + DFF + cc), w2 = *(const f32x4*)(cwp + 2 * DFF + cc), bb = *(const f32x4*)(cbp + cc);
            float a0[4], a1[4];
#pragma unroll
            for (int e = 0; e < 4; ++e) { const float ga = bb[e] + w0[e] * gm2[e] + w1[e] * gm1[e] + w2[e] * g0[e], gb = bb[e] + w0[e] * gm1[e] + w1[e] * g0[e] + w2[e] * g1[e];
                a0[e] = ga * fsigmoid(ga) * u0[e]; a1[e] = gb * fsigmoid(gb) * u1[e]; }
            *(uint2*)(ACT + cc) = (uint2){pk2bf(a0[0], a0[1]), pk2bf(a0[2], a0[3])}; *(uint2*)(ACT + DFF + cc) = (uint2){pk2bf(a1[0], a1[1]), pk2bf(a1[2], a1[3])}; }
    }
}
__device__ __forceinline__ void ph_finalnorm(const Params& P, int bid, int nb) {
    const int tid_ = opaque_tid(), lane = tid_ & 63, wave = tid_ >> 6;
    f32x4 gg[8];
#pragma unroll
    for (int j = 0; j < 8; ++j) gg[j] = *(const f32x4*)(P.final_g + j * 256 + lane * 4);
    for (int row = (bid * 8 + wave) * 2; row < M; row += nb * 16) { float* xr = P.out + (size_t)row * DM; const _Float16* xhr = WSP(const _Float16, WS_XH) + (size_t)row * DM;
        f32x4 v0[8], v1[8]; float ss0 = 0.f, ss1 = 0.f;
        { pg8::h16x4 t0[8], t1[8];
#pragma unroll
            for (int j = 0; j < 8; ++j) { t0[j] = *(const pg8::h16x4*)(xhr + j * 256 + lane * 4); t1[j] = *(const pg8::h16x4*)(xhr + DM + j * 256 + lane * 4); }
#pragma unroll
            for (int j = 0; j < 8; ++j) { v0[j] = __builtin_convertvector(t0[j], f32x4); v1[j] = __builtin_convertvector(t1[j], f32x4); } }
#pragma unroll
        for (int j = 0; j < 8; ++j) { ss0 += v0[j][0] * v0[j][0] + v0[j][1] * v0[j][1] + v0[j][2] * v0[j][2] + v0[j][3] * v0[j][3];
                                      ss1 += v1[j][0] * v1[j][0] + v1[j][1] * v1[j][1] + v1[j][2] * v1[j][2] + v1[j][3] * v1[j][3]; }
        ss0 = wave_sum(ss0); ss1 = wave_sum(ss1);
        const float r0 = rsqrtf(ss0 * (1.f / DM) + 1e-6f), r1 = rsqrtf(ss1 * (1.f / DM) + 1e-6f);
#pragma unroll
        for (int j = 0; j < 8; ++j) { const int i0 = j * 256 + lane * 4; *(f32x4*)(xr + i0) = v0[j] * r0 * gg[j]; *(f32x4*)(xr + DM + i0) = v1[j] * r1 * gg[j]; } }
}
constexpr int CW_SPLIT = 10240;
__device__ __forceinline__ void split_arrive(unsigned* cnt) {
    asm volatile("s_waitcnt vmcnt(0)" ::: "memory"); __syncthreads();
    if (threadIdx.x == 0) { __builtin_amdgcn_fence(__ATOMIC_RELEASE, "agent"); asm volatile("s_waitcnt vmcnt(0)" ::: "memory");
        (void)__hip_atomic_fetch_add(cnt, 1u, __ATOMIC_RELAXED, __HIP_MEMORY_SCOPE_AGENT); }
}
__device__ __forceinline__ void split_wait(unsigned* cnt, unsigned want, unsigned* tmo) {
    if (threadIdx.x == 0) { unsigned sp = 0;
        while (__hip_atomic_load(cnt, __ATOMIC_RELAXED, __HIP_MEMORY_SCOPE_AGENT) < want) { __builtin_amdgcn_s_sleep(1);
            if ((++sp & 255u) == 0u) { if (__hip_atomic_load(tmo, __ATOMIC_RELAXED, __HIP_MEMORY_SCOPE_AGENT)) break; if (sp > (1u << 18)) { atomicAdd(tmo, 1u); break; } } }
        __builtin_amdgcn_fence(__ATOMIC_ACQUIRE, "agent"); asm volatile("s_waitcnt vmcnt(0)" ::: "memory"); }
    __syncthreads();
}
typedef fox::BlockRef<fox::bf16, fox::bf16> FoxRef;
constexpr size_t WS_SMIN = WS_SPT + 64 * 1024;
__device__ __forceinline__ void ph_selfmin(const Params& P, char* lds, int bid, int nb) {
    const int tid = opaque_tid(), lane = tid & 63, wave = tid >> 6, c = lane & 15, r4 = lane >> 4;
    const bf16_t* Q = WSP(const bf16_t, WS_Q); const bf16_t* K = WSP(const bf16_t, WS_K); float* red = (float*)lds;
    for (int p = bid; p < 512; p += nb) {
        const size_t base = ((size_t)p * 256 + wave * 32 + r4) * 128 + c * 8;
        u32x4 qv[8], kv[8];
#pragma unroll
        for (int it = 0; it < 8; ++it) { qv[it] = *(const u32x4*)(Q + base + (size_t)it * 4 * 128); kv[it] = *(const u32x4*)(K + base + (size_t)it * 4 * 128); }
        float mn = 1e30f;
#pragma unroll
        for (int it = 0; it < 8; ++it) { float qf[8], kf[8]; UNPACK8(qv[it], qf); UNPACK8(kv[it], kf);
            float d = (qf[0] * kf[0] + qf[1] * kf[1]) + (qf[2] * kf[2] + qf[3] * kf[3]) + (qf[4] * kf[4] + qf[5] * kf[5]) + (qf[6] * kf[6] + qf[7] * kf[7]);
            d += __builtin_bit_cast(float, __builtin_amdgcn_ds_swizzle(__builtin_bit_cast(int, d), 0x041f)); d += __builtin_bit_cast(float, __builtin_amdgcn_ds_swizzle(__builtin_bit_cast(int, d), 0x081f));
            d += __builtin_bit_cast(float, __builtin_amdgcn_ds_swizzle(__builtin_bit_cast(int, d), 0x101f)); d += __builtin_bit_cast(float, __builtin_amdgcn_ds_swizzle(__builtin_bit_cast(int, d), 0x201f));
            mn = fminf(mn, d); }
        mn = fminf(mn, __builtin_bit_cast(float, __builtin_amdgcn_ds_swizzle(__builtin_bit_cast(int, mn), 0x401f)));
        { const auto rr = __builtin_amdgcn_permlane32_swap(__builtin_bit_cast(unsigned, mn), __builtin_bit_cast(unsigned, mn), false, false); mn = fminf(__builtin_bit_cast(float, rr[0]), __builtin_bit_cast(float, rr[1])); }
        if (lane == 0) red[wave] = mn;
        __syncthreads();
        if (tid == 0) { float m8 = red[0];
#pragma unroll
            for (int w = 1; w < 8; ++w) m8 = fminf(m8, red[w]);
            WSP(float, WS_SMIN)[p] = fminf(m8 * fox::SCALE, 0.f); }
        __syncthreads();
    }
}
constexpr int CW_NRM = 12288;
constexpr size_t WS_ATST = WS_SCR + 16 * MiB;
constexpr int LDS_ATAB = 69632;
constexpr int LDS_CMB = LDS_MISC + 128;
constexpr int FOX_OVH = 4;
struct FoxCut { int start, end, v; };
__device__ __forceinline__ FoxRef fox_piece(int i, const FoxCut& c, const int* nt, const int* pe, const bf16_t* Q, const bf16_t* K, const bf16_t* V, const float* F, bf16_t* Y, float* ST) {
    const int bh = i >> 5, qb = 31 - (i & 31), b = bh >> 3, hh = bh & 7, ntb = nt[i], p0 = pe[i];
    const int ta = c.start > p0 + FOX_OVH ? c.start - p0 - FOX_OVH : 0, tb = (c.end - p0 - FOX_OVH < ntb) ? c.end - p0 - FOX_OVH : ntb;
    FoxRef r; const size_t ho = (size_t)bh * SEQ * 128;
    r.Q = Q + ho + (size_t)qb * 256 * 128; r.K = K + ho; r.V = V + ho; r.O = Y + ((size_t)b * SEQ + qb * 256) * DM + 512 + hh * 128;
    r.F = F + (size_t)bh * SEQ; r.fref = r.F[qb * 256]; r.P0 = qb * 256;
    r.jhi = 4 * qb + 4 - ta; r.jlo = 4 * qb + 4 - tb;
    r.st = (tb - ta < ntb) ? ST + (size_t)(c.v * 2 + (ta > 0 ? 0 : 1)) * (512 * 68) : nullptr;
    return r;
}
__device__ __forceinline__ void ph_attn(const Params& P, char* lds, int l, int bid, int nb) {
    const bf16_t* Q = WSP(const bf16_t, WS_Q); const bf16_t* K = WSP(const bf16_t, WS_K); const bf16_t* V = WSP(const bf16_t, WS_V); const float* F = WSP(const float, WS_F); bf16_t* Y = WSP(bf16_t, WS_Y);
    const unsigned* nrm = WSP(const unsigned, WS_CTL) + CW_NRM + l * 128; float* ST = WSP(float, WS_ATST);
    const int tid = opaque_tid();
    int* nt = (int*)(lds + LDS_ATAB); int* pe = nt + 512; volatile int* cmb = (volatile int*)(lds + LDS_CMB); volatile int* first = (volatile int*)(lds + LDS_ATAB + 8192);
    { const int i = tid, bh = i >> 5, qb = 31 - (i & 31); const float* Fh = F + (size_t)bh * SEQ; const unsigned* n8 = nrm + bh * 8;
        const float q2 = (__uint_as_float(n8[0]) + __uint_as_float(n8[1])) + (__uint_as_float(n8[2]) + __uint_as_float(n8[3])), k2 = (__uint_as_float(n8[4]) + __uint_as_float(n8[5])) + (__uint_as_float(n8[6]) + __uint_as_float(n8[7]));
        const float thr = Fh[qb * 256] + 89.f + 1.02f * fox::SCALE * sqrtf(q2 * k2) - WSP(const float, WS_SMIN)[bh * 32 + qb];
        int lo = 0, hi_ = qb * 4;
        while (lo < hi_) { const int mid = (lo + hi_) >> 1; if (Fh[mid * 64 + 63] > thr) lo = mid + 1; else hi_ = mid; }
        const int n = 4 * qb + 4 - lo; nt[i] = n;
        int val = n + FOX_OVH;
        for (int d = 1; d < 512; d <<= 1) { pe[i] = val; __syncthreads(); if (i >= d) val += pe[i - d]; __syncthreads(); }
        pe[i] = val - n - FOX_OVH; if (i == 511) pe[512] = val; if (i == 0) { cmb[0] = -1; cmb[1] = 0; }
    }
    __syncthreads();
    FoxCut c; { const int T = pe[512]; c.v = (nb % 8 == 0) ? (bid & 7) * (nb >> 3) + (bid >> 3) : bid;
        c.start = (int)((unsigned)(c.v * T) / (unsigned)nb); c.end = (int)((unsigned)((c.v + 1) * T) / (unsigned)nb);
        if (c.end <= c.start) return;
        if (pe[tid] <= c.start && c.start < pe[tid] + nt[tid] + FOX_OVH) first[0] = tid;
        __syncthreads();
        const int i0 = __builtin_amdgcn_readfirstlane(first[0]);
        { const int il = tid, f0 = pe[il] + FOX_OVH; if (f0 >= c.start && f0 < c.end && f0 + nt[il] > c.end) { cmb[0] = il; cmb[1] = (int)((unsigned)((f0 + nt[il]) * nb - 1) / (unsigned)T); } }
        int i = i0; FoxRef cur = fox_piece(i, c, nt, pe, Q, K, V, F, Y, ST);
        fox::Seam<fox::bf16> S;
        fox::causal_swa_prime<fox::bf16, fox::bf16>(cur, SEQ, lds, S);
        for (;;) {
            const int in = i + 1; const bool more = in < 512 && __builtin_amdgcn_readfirstlane(pe[in < 512 ? in : 511]) + FOX_OVH < c.end;
            const FoxRef nxt = more ? fox_piece(in, c, nt, pe, Q, K, V, F, Y, ST) : cur;
            fox::causal_swa_block<fox::bf16, fox::bf16>(cur, nxt, SEQ, SEQ, lds, S);
            if (!more) break;
            cur = nxt; i = in;
        }
    }
}
__device__ __forceinline__ void ph_attn_combine(const Params& P, char* lds, int bid, int nb) {
    volatile int* cmb = (volatile int*)(lds + LDS_CMB);
    const int blk = __builtin_amdgcn_readfirstlane(cmb[0]), wlast = __builtin_amdgcn_readfirstlane(cmb[1]);
    if (blk < 0) return;
    const int tid = opaque_tid(), lane = tid & 63, wid = tid >> 6, r32 = lane & 31, hi = lane >> 5;
    const int v = (nb % 8 == 0) ? (bid & 7) * (nb >> 3) + (bid >> 3) : bid, bh = blk >> 5, qb = 31 - (blk & 31);
    const float* ST = WSP(const float, WS_ATST); float* ws = (float*)lds + wid * 64;
    constexpr float C2 = 1.4426950408889634f * fox::SCALE;
    float Mx = -1e30f, L = 0.f; fox::f32x16 o[4] = {};
    for (int w = v; w <= wlast; ++w) {
        const float* sp = ST + ((size_t)(w * 2 + (w == v ? 1 : 0)) * 512 + wid * 64) * 68 + lane * 4;
        const f32x4 ml = *(const f32x4*)(sp + 16 * 256); const float Mn = fmaxf(Mx, ml[0]);
        const float ao = __builtin_amdgcn_exp2f((Mx - Mn) * C2), an = __builtin_amdgcn_exp2f((ml[0] - Mn) * C2);
        L = L * ao + ml[1] * an; Mx = Mn;
        if (hi == 0) { ws[r32] = ao; ws[32 + r32] = an; }
        asm volatile("s_waitcnt lgkmcnt(0)" ::: "memory");
#pragma unroll
        for (int d0 = 0; d0 < 4; ++d0)
#pragma unroll
            for (int q4 = 0; q4 < 4; ++q4) { const f32x4 pv = *(const f32x4*)(sp + (d0 * 4 + q4) * 256);
#pragma unroll
                for (int e = 0; e < 4; ++e) { const int r = q4 * 4 + e, row = fox::crow(r, hi); o[d0][r] = o[d0][r] * ws[row] + pv[e] * ws[32 + row]; } }
        asm volatile("s_waitcnt lgkmcnt(0)" ::: "memory");
    }
    if (hi == 0) ws[r32] = L;
    asm volatile("s_waitcnt lgkmcnt(0)" ::: "memory");
    bf16_t* Ow = WSP(bf16_t, WS_Y) + ((size_t)(bh >> 3) * SEQ + qb * 256 + wid * 32) * DM + 512 + (bh & 7) * 128;
#pragma unroll
    for (int r = 0; r < 16; ++r) { const int orow = fox::crow(r, hi); const float rl = __builtin_amdgcn_rcpf(ws[orow]);
#pragma unroll
        for (int d0 = 0; d0 < 4; ++d0) { const float vv = o[d0][r] * rl;
            const float vn = __builtin_bit_cast(float, __builtin_amdgcn_mov_dpp(__builtin_bit_cast(int, vv), 0xB1, 0xF, 0xF, true));
            if ((r32 & 1) == 0) *(unsigned*)(Ow + (size_t)orow * DM + d0 * 32 + r32) = fox::cvtpk(vv, vn); } }
}

#define XB_TMO      128
#define XB_XCNT(j)  (256  + 64 * (j))
#define XB_XSUB(j)  (1280 + 64 * (j))
#define XB_XGEN(j)  (2304 + 64 * (j))
#define XB_TOP      3328
#define XB_TOPGEN   3392
#define XCD_BAR_WORDS 3456
#define XB_SPIN_CAP (1u << 18)

__device__ __forceinline__ unsigned xb_ld(unsigned* p)              { return __hip_atomic_load(p, __ATOMIC_RELAXED, __HIP_MEMORY_SCOPE_AGENT); }
__device__ __forceinline__ unsigned xb_add(unsigned* p, unsigned v) { return __hip_atomic_fetch_add(p, v, __ATOMIC_RELAXED, __HIP_MEMORY_SCOPE_AGENT); }
__device__ __forceinline__ unsigned xb_xcc_id() { return (unsigned)__builtin_amdgcn_s_getreg((3 << 11) | 20) & 0xFu; }
#define XB_SPIN(cond, bar) do { unsigned _sp = 0; while (cond) { __builtin_amdgcn_s_sleep(1); \
    if ((++_sp & 255u) == 0u) { if (xb_ld(&(bar)[XB_TMO])) break; if (_sp > XB_SPIN_CAP) { atomicAdd(&(bar)[XB_TMO], 1u); break; } } } } while (0)

struct XcdBarrier {
    unsigned* bar; unsigned x;
    volatile LAS unsigned* st;
};

__device__ __forceinline__ XcdBarrier xcd_barrier_post(unsigned* bar, volatile LAS unsigned* st) {
    XcdBarrier b; b.bar = bar; b.x = xb_xcc_id(); b.st = st;
    if (threadIdx.x == 0) (void)xb_add(&bar[XB_XCNT(b.x)], 1u);
    return b;
}
__device__ __forceinline__ void xcd_barrier_complete(unsigned* bar, unsigned x, unsigned& nloc, unsigned& nx) {
    const unsigned G = gridDim.x * gridDim.y * gridDim.z;
    unsigned sum, cnt, mine, sp = 0u;
    for (;;) {
        sum = 0u; cnt = 0u; mine = 0u;
#pragma unroll
        for (unsigned j = 0; j < 16; ++j) { const unsigned c = xb_ld(&bar[XB_XCNT(j)]); sum += c; cnt += (c > 0u) ? 1u : 0u; mine = (j == x) ? c : mine; }
        if (sum == G) break;
        __builtin_amdgcn_s_sleep(1);
        if ((++sp & 255u) == 0u) { if (xb_ld(&bar[XB_TMO])) break; if (sp > XB_SPIN_CAP) { atomicAdd(&bar[XB_TMO], 1u); break; } }
    }
    nloc = mine > 0u ? mine : 1u; nx = cnt > 0u ? cnt : 1u;
}

__device__ __forceinline__ void xcd_barrier(const XcdBarrier& b) {
    asm volatile("s_waitcnt vmcnt(0)" ::: "memory");
    __syncthreads();
    if (threadIdx.x == 0) {
        unsigned* bar = b.bar;
        __builtin_amdgcn_s_waitcnt(0);
        unsigned nloc = b.st[0], nx = b.st[1];
        if (nloc == 0u) { xcd_barrier_complete(bar, b.x, nloc, nx); b.st[0] = nloc; b.st[1] = nx; }
        const unsigned old = xb_add(&bar[XB_XSUB(b.x)], 1u);
        const unsigned gen = old / nloc;
        if (old + 1u == (gen + 1u) * nloc) {
            __builtin_amdgcn_fence(__ATOMIC_RELEASE, "agent");
            asm volatile("s_waitcnt vmcnt(0)" ::: "memory");
            const unsigned og = xb_add(&bar[XB_TOP], 1u);
            const unsigned tg = og / nx;
            if (og + 1u == (tg + 1u) * nx) xb_add(&bar[XB_TOPGEN], 1u);
            else XB_SPIN(xb_ld(&bar[XB_TOPGEN]) == tg, bar);
            __builtin_amdgcn_fence(__ATOMIC_ACQUIRE, "agent");
            xb_add(&bar[XB_XGEN(b.x)], 1u);
            asm volatile("s_waitcnt vmcnt(0)" ::: "memory");
        } else {
            XB_SPIN(xb_ld(&bar[XB_XGEN(b.x)]) == gen, bar);
            __builtin_amdgcn_fence(__ATOMIC_ACQUIRE, "agent");
            asm volatile("s_waitcnt vmcnt(0)" ::: "memory");
        }
    }
    __syncthreads();
}

#ifndef ONE_LAUNCH
#define ONE_LAUNCH 1
#endif
__global__ void __launch_bounds__(NTHR, 2) fox_fwd(Params PA, int ph_lo, int ph_hi) {
    extern __shared__ __attribute__((aligned(16))) unsigned char lds_dyn[];
    char* lds = (char*)lds_dyn; PG8_LAS unsigned char* lds3 = (PG8_LAS unsigned char*)lds_dyn;
    const int tid = threadIdx.x, bid0 = blockIdx.x, nb0 = gridDim.x;
    LAS unsigned* ptab = (LAS unsigned*)(lds3 + LDS_PTAB);
    store_params(ptab, PA);
    if (tid < 256) ((LAS unsigned*)(lds3 + LDS_RING))[tid] = 0u;
    __syncthreads();
    XcdBarrier bar; bar.bar = (unsigned*)(PA.ws + WS_CTL) + CW_BAR; bar.x = 0; bar.st = nullptr;
    if (ph_hi - ph_lo > 1) bar = xcd_barrier_post((unsigned*)(PA.ws + WS_CTL) + CW_BAR, (volatile LAS unsigned*)(lds3 + LDS_MISC) + 8);
    __syncthreads();
#define PL const Params P = load_params(ptab); int bid = bid0, nb = nb0; asm volatile("" : "+s"(bid), "+s"(nb))
#define IN(k) (ph_lo <= (k) && (k) < ph_hi)
#define SEAM(k) do { if (IN((k) + 1)) { XcdBarrier xb_ = bar; asm volatile("" : "+s"(xb_.bar), "+s"(xb_.x));     \
        xcd_barrier(xb_); } } while (0)
    if (IN(0)) { PL; ph_prologue(P, lds, bid, nb); SEAM(0); }
    { constexpr int l = 0;
        const int pb = 1 + 8 * l;
        if (IN(pb + 0)) { PL; ph_norm<0, l == 0>(P, lds, l, bid, nb); SEAM(pb + 0); }
        if (IN(pb + 1)) { PL; pg8::Gemm g{WSP(bf16_t, WS_H), WSP(bf16_t, WS_WIN) + (size_t)l * NZ * DM, M, NZ, DM}; pg8::StaticOrder S; S.init(M, NZ, nb, bid);
            static_assert(WS_K - WS_Q == 2 * pg8::EpiZr::QKV_STRIDE && WS_V - WS_K == 2 * pg8::EpiZr::QKV_STRIDE, "Q | K | V spacing");
            pg8::EpiZr E{WSP(bf16_t, WS_ZP), WSP(bf16_t, WS_Q), WSP(bf16_t, WS_ZX), WSP(bf16_t, WS_ZY), WSP(unsigned, WS_CTL) + CW_NRM + l * 128, (PG8_LAS float*)(lds3 + LDS_RING + 8192)};
            pg8::gemm_phase<pg8::EpiZr, pg8::StaticOrder, true, true>(lds3, g, S, E);
            if (bid >= nb - 2) { const int w_ = opaque_tid() >> 6; for (int bh = (bid - (nb - 2)) * 8 + w_; bh < 16; bh += 16) fscan_wave(P, lds, bh); }
            { const int nun = (M / 256) * (NZ / 256), umax = (nun + nb - 1) / nb, first_short = nun - (umax - 1) * nb;
              if (l + 1 < DEPTH && first_short < nb && bid >= first_short) { __syncthreads(); ada_layer(P, lds, l + 1, bid - first_short, nb - first_short); }
              else if (l + 1 < DEPTH && first_short >= nb) { __syncthreads(); ada_layer(P, lds, l + 1, bid, nb); } }
            SEAM(pb + 1); }
        if (IN(pb + 2)) { PL; unsigned* ctl_ = WSP(unsigned, WS_CTL); ph_selfmin(P, lds, bid, nb); split_arrive(ctl_ + CW_SPLIT + 64 * l + 32);
            ph_mixprep(P, lds, l, bid, nb); split_arrive(ctl_ + CW_SPLIT + 64 * l); split_wait(ctl_ + CW_SPLIT + 64 * l + 32, (unsigned)nb, ctl_ + CW_BAR + XB_TMO);
            ph_attn(P, lds, l, bid, nb); __syncthreads(); split_wait(ctl_ + CW_SPLIT + 64 * l, (unsigned)nb, ctl_ + CW_BAR + XB_TMO);
            for (int u = bid; u < 256; u += nb) lru_fixup_tile(P, lds, u); SEAM(pb + 2); }
        if (IN(pb + 3)) { PL; ph_attn_combine(P, lds, bid, nb); SEAM(pb + 3); }
        if (IN(pb + 4)) { PL; const float* modl = WSP(float, WS_MOD) + (size_t)l * 2 * NADA; pg8::Gemm g{WSP(bf16_t, WS_Y), WSP(bf16_t, WS_WOUT) + (size_t)l * DM * DM, M, DM, DM}; pg8::StaticOrder S; S.init(M, DM, nb, bid);
            pg8::EpiResid<false> E{P.x_in, WSP(const _Float16, WS_XH), WSP(_Float16, WS_XH), modl + 2 * DM};
            pg8::gemm_phase<pg8::EpiResid<false>, pg8::StaticOrder, true, true>(lds3, g, S, E); SEAM(pb + 4); }
        if (IN(pb + 5)) { PL; ph_norm<1, false>(P, lds, l, bid, nb); SEAM(pb + 5); }
        if (IN(pb + 6)) { PL; pg8::Gemm g{WSP(bf16_t, WS_H), WSP(bf16_t, WS_WGU) + (size_t)l * NGU * DM, M, NGU, DM}; pg8::StaticOrder S; S.init(M, NGU, nb, bid);
            pg8::EpiGUAct E{WSP(bf16_t, WS_ACT), P.ffn_cw + (size_t)l * 3 * DFF, P.ffn_cb + l * DFF, WSP(float, WS_SIDE), (PG8_LAS float*)(lds3 + LDS_HALO)};
            pg8::gemm_phase<pg8::EpiGUAct, pg8::StaticOrder, true, true>(lds3, g, S, E); SEAM(pb + 6); }
        if (IN(pb + 7)) { PL; const float* modl = WSP(float, WS_MOD) + (size_t)l * 2 * NADA; pg8::Gemm g{WSP(bf16_t, WS_ACT), WSP(bf16_t, WS_WDN) + (size_t)l * DM * DFF, M, DM, DFF}; pg8::StaticOrder S; S.init(M, DM, nb, bid);
            { pg8::StaticOrder Sf; Sf.init(M, DM, nb, bid); pg8::Unit u0, u1; const bool h0 = Sf.next(0, u0), h1 = Sf.next(1, u1);
              if (nb * 2 >= (M / 256) * (DM / 256)) { if (h0) ffn_fix_tile(P, l, u0.pm); if (h1 && u1.pm != u0.pm) ffn_fix_tile(P, l, u1.pm); }
              else { for (int t = 0; t < M / 256; ++t) ffn_fix_tile(P, l, t); }
              asm volatile("s_waitcnt vmcnt(0)" ::: "memory"); __syncthreads(); }
            pg8::EpiResid<false> E{P.x_in, WSP(const _Float16, WS_XH), WSP(_Float16, WS_XH), modl + 5 * DM};
            pg8::gemm_phase<pg8::EpiResid<false>, pg8::StaticOrder, true, true>(lds3, g, S, E); SEAM(pb + 7); }
        }
    { constexpr int l = 1;
        const int pb = 1 + 8 * l;
        if (IN(pb + 0)) { PL; ph_norm<0, l == 0>(P, lds, l, bid, nb); SEAM(pb + 0); }
        if (IN(pb + 1)) { PL; pg8::Gemm g{WSP(bf16_t, WS_H), WSP(bf16_t, WS_WIN) + (size_t)l * NZ * DM, M, NZ, DM}; pg8::StaticOrder S; S.init(M, NZ, nb, bid);
            static_assert(WS_K - WS_Q == 2 * pg8::EpiZr::QKV_STRIDE && WS_V - WS_K == 2 * pg8::EpiZr::QKV_STRIDE, "Q | K | V spacing");
            pg8::EpiZr E{WSP(bf16_t, WS_ZP), WSP(bf16_t, WS_Q), WSP(bf16_t, WS_ZX), WSP(bf16_t, WS_ZY), WSP(unsigned, WS_CTL) + CW_NRM + l * 128, (PG8_LAS float*)(lds3 + LDS_RING + 8192)};
            pg8::gemm_phase<pg8::EpiZr, pg8::StaticOrder, true, true>(lds3, g, S, E);
            if (bid >= nb - 2) { const int w_ = opaque_tid() >> 6; for (int bh = (bid - (nb - 2)) * 8 + w_; bh < 16; bh += 16) fscan_wave(P, lds, bh); }
            { const int nun = (M / 256) * (NZ / 256), umax = (nun + nb - 1) / nb, first_short = nun - (umax - 1) * nb;
              if (l + 1 < DEPTH && first_short < nb && bid >= first_short) { __syncthreads(); ada_layer(P, lds, l + 1, bid - first_short, nb - first_short); }
              else if (l + 1 < DEPTH && first_short >= nb) { __syncthreads(); ada_layer(P, lds, l + 1, bid, nb); } }
            SEAM(pb + 1); }
        if (IN(pb + 2)) { PL; unsigned* ctl_ = WSP(unsigned, WS_CTL); ph_selfmin(P, lds, bid, nb); split_arrive(ctl_ + CW_SPLIT + 64 * l + 32);
            ph_mixprep(P, lds, l, bid, nb); split_arrive(ctl_ + CW_SPLIT + 64 * l); split_wait(ctl_ + CW_SPLIT + 64 * l + 32, (unsigned)nb, ctl_ + CW_BAR + XB_TMO);
            ph_attn(P, lds, l, bid, nb); __syncthreads(); split_wait(ctl_ + CW_SPLIT + 64 * l, (unsigned)nb, ctl_ + CW_BAR + XB_TMO);
            for (int u = bid; u < 256; u += nb) lru_fixup_tile(P, lds, u); SEAM(pb + 2); }
        if (IN(pb + 3)) { PL; ph_attn_combine(P, lds, bid, nb); SEAM(pb + 3); }
        if (IN(pb + 4)) { PL; const float* modl = WSP(float, WS_MOD) + (size_t)l * 2 * NADA; pg8::Gemm g{WSP(bf16_t, WS_Y), WSP(bf16_t, WS_WOUT) + (size_t)l * DM * DM, M, DM, DM}; pg8::StaticOrder S; S.init(M, DM, nb, bid);
            pg8::EpiResid<false> E{P.x_in, WSP(const _Float16, WS_XH), WSP(_Float16, WS_XH), modl + 2 * DM};
            pg8::gemm_phase<pg8::EpiResid<false>, pg8::StaticOrder, true, true>(lds3, g, S, E); SEAM(pb + 4); }
        if (IN(pb + 5)) { PL; ph_norm<1, false>(P, lds, l, bid, nb); SEAM(pb + 5); }
        if (IN(pb + 6)) { PL; pg8::Gemm g{WSP(bf16_t, WS_H), WSP(bf16_t, WS_WGU) + (size_t)l * NGU * DM, M, NGU, DM}; pg8::StaticOrder S; S.init(M, NGU, nb, bid);
            pg8::EpiGUAct E{WSP(bf16_t, WS_ACT), P.ffn_cw + (size_t)l * 3 * DFF, P.ffn_cb + l * DFF, WSP(float, WS_SIDE), (PG8_LAS float*)(lds3 + LDS_HALO)};
            pg8::gemm_phase<pg8::EpiGUAct, pg8::StaticOrder, true, true>(lds3, g, S, E); SEAM(pb + 6); }
        if (IN(pb + 7)) { PL; const float* modl = WSP(float, WS_MOD) + (size_t)l * 2 * NADA; pg8::Gemm g{WSP(bf16_t, WS_ACT), WSP(bf16_t, WS_WDN) + (size_t)l * DM * DFF, M, DM, DFF}; pg8::StaticOrder S; S.init(M, DM, nb, bid);
            { pg8::StaticOrder Sf; Sf.init(M, DM, nb, bid); pg8::Unit u0, u1; const bool h0 = Sf.next(0, u0), h1 = Sf.next(1, u1);
              if (nb * 2 >= (M / 256) * (DM / 256)) { if (h0) ffn_fix_tile(P, l, u0.pm); if (h1 && u1.pm != u0.pm) ffn_fix_tile(P, l, u1.pm); }
              else { for (int t = 0; t < M / 256; ++t) ffn_fix_tile(P, l, t); }
              asm volatile("s_waitcnt vmcnt(0)" ::: "memory"); __syncthreads(); }
            pg8::EpiResid<false> E{P.x_in, WSP(const _Float16, WS_XH), WSP(_Float16, WS_XH), modl + 5 * DM};
            pg8::gemm_phase<pg8::EpiResid<false>, pg8::StaticOrder, true, true>(lds3, g, S, E); SEAM(pb + 7); }
        }
    { constexpr int l = 2;
        const int pb = 1 + 8 * l;
        if (IN(pb + 0)) { PL; ph_norm<0, l == 0>(P, lds, l, bid, nb); SEAM(pb + 0); }
        if (IN(pb + 1)) { PL; pg8::Gemm g{WSP(bf16_t, WS_H), WSP(bf16_t, WS_WIN) + (size_t)l * NZ * DM, M, NZ, DM}; pg8::StaticOrder S; S.init(M, NZ, nb, bid);
            static_assert(WS_K - WS_Q == 2 * pg8::EpiZr::QKV_STRIDE && WS_V - WS_K == 2 * pg8::EpiZr::QKV_STRIDE, "Q | K | V spacing");
            pg8::EpiZr E{WSP(bf16_t, WS_ZP), WSP(bf16_t, WS_Q), WSP(bf16_t, WS_ZX), WSP(bf16_t, WS_ZY), WSP(unsigned, WS_CTL) + CW_NRM + l * 128, (PG8_LAS float*)(lds3 + LDS_RING + 8192)};
            pg8::gemm_phase<pg8::EpiZr, pg8::StaticOrder, true, true>(lds3, g, S, E);
            if (bid >= nb - 2) { const int w_ = opaque_tid() >> 6; for (int bh = (bid - (nb - 2)) * 8 + w_; bh < 16; bh += 16) fscan_wave(P, lds, bh); }
            { const int nun = (M / 256) * (NZ / 256), umax = (nun + nb - 1) / nb, first_short = nun - (umax - 1) * nb;
              if (l + 1 < DEPTH && first_short < nb && bid >= first_short) { __syncthreads(); ada_layer(P, lds, l + 1, bid - first_short, nb - first_short); }
              else if (l + 1 < DEPTH && first_short >= nb) { __syncthreads(); ada_layer(P, lds, l + 1, bid, nb); } }
            SEAM(pb + 1); }
        if (IN(pb + 2)) { PL; unsigned* ctl_ = WSP(unsigned, WS_CTL); ph_selfmin(P, lds, bid, nb); split_arrive(ctl_ + CW_SPLIT + 64 * l + 32);
            ph_mixprep(P, lds, l, bid, nb); split_arrive(ctl_ + CW_SPLIT + 64 * l); split_wait(ctl_ + CW_SPLIT + 64 * l + 32, (unsigned)nb, ctl_ + CW_BAR + XB_TMO);
            ph_attn(P, lds, l, bid, nb); __syncthreads(); split_wait(ctl_ + CW_SPLIT + 64 * l, (unsigned)nb, ctl_ + CW_BAR + XB_TMO);
            for (int u = bid; u < 256; u += nb) lru_fixup_tile(P, lds, u); SEAM(pb + 2); }
        if (IN(pb + 3)) { PL; ph_attn_combine(P, lds, bid, nb); SEAM(pb + 3); }
        if (IN(pb + 4)) { PL; const float* modl = WSP(float, WS_MOD) + (size_t)l * 2 * NADA; pg8::Gemm g{WSP(bf16_t, WS_Y), WSP(bf16_t, WS_WOUT) + (size_t)l * DM * DM, M, DM, DM}; pg8::StaticOrder S; S.init(M, DM, nb, bid);
            pg8::EpiResid<false> E{P.x_in, WSP(const _Float16, WS_XH), WSP(_Float16, WS_XH), modl + 2 * DM};
            pg8::gemm_phase<pg8::EpiResid<false>, pg8::StaticOrder, true, true>(lds3, g, S, E); SEAM(pb + 4); }
        if (IN(pb + 5)) { PL; ph_norm<1, false>(P, lds, l, bid, nb); SEAM(pb + 5); }
        if (IN(pb + 6)) { PL; pg8::Gemm g{WSP(bf16_t, WS_H), WSP(bf16_t, WS_WGU) + (size_t)l * NGU * DM, M, NGU, DM}; pg8::StaticOrder S; S.init(M, NGU, nb, bid);
            pg8::EpiGUAct E{WSP(bf16_t, WS_ACT), P.ffn_cw + (size_t)l * 3 * DFF, P.ffn_cb + l * DFF, WSP(float, WS_SIDE), (PG8_LAS float*)(lds3 + LDS_HALO)};
            pg8::gemm_phase<pg8::EpiGUAct, pg8::StaticOrder, true, true>(lds3, g, S, E); SEAM(pb + 6); }
        if (IN(pb + 7)) { PL; const float* modl = WSP(float, WS_MOD) + (size_t)l * 2 * NADA; pg8::Gemm g{WSP(bf16_t, WS_ACT), WSP(bf16_t, WS_WDN) + (size_t)l * DM * DFF, M, DM, DFF}; pg8::StaticOrder S; S.init(M, DM, nb, bid);
            { pg8::StaticOrder Sf; Sf.init(M, DM, nb, bid); pg8::Unit u0, u1; const bool h0 = Sf.next(0, u0), h1 = Sf.next(1, u1);
              if (nb * 2 >= (M / 256) * (DM / 256)) { if (h0) ffn_fix_tile(P, l, u0.pm); if (h1 && u1.pm != u0.pm) ffn_fix_tile(P, l, u1.pm); }
              else { for (int t = 0; t < M / 256; ++t) ffn_fix_tile(P, l, t); }
              asm volatile("s_waitcnt vmcnt(0)" ::: "memory"); __syncthreads(); }
            pg8::EpiResid<false> E{P.x_in, WSP(const _Float16, WS_XH), WSP(_Float16, WS_XH), modl + 5 * DM};
            pg8::gemm_phase<pg8::EpiResid<false>, pg8::StaticOrder, true, true>(lds3, g, S, E); SEAM(pb + 7); }
        }
    { constexpr int l = 3;
        const int pb = 1 + 8 * l;
        if (IN(pb + 0)) { PL; ph_norm<0, l == 0>(P, lds, l, bid, nb); SEAM(pb + 0); }
        if (IN(pb + 1)) { PL; pg8::Gemm g{WSP(bf16_t, WS_H), WSP(bf16_t, WS_WIN) + (size_t)l * NZ * DM, M, NZ, DM}; pg8::StaticOrder S; S.init(M, NZ, nb, bid);
            static_assert(WS_K - WS_Q == 2 * pg8::EpiZr::QKV_STRIDE && WS_V - WS_K == 2 * pg8::EpiZr::QKV_STRIDE, "Q | K | V spacing");
            pg8::EpiZr E{WSP(bf16_t, WS_ZP), WSP(bf16_t, WS_Q), WSP(bf16_t, WS_ZX), WSP(bf16_t, WS_ZY), WSP(unsigned, WS_CTL) + CW_NRM + l * 128, (PG8_LAS float*)(lds3 + LDS_RING + 8192)};
            pg8::gemm_phase<pg8::EpiZr, pg8::StaticOrder, true, true>(lds3, g, S, E);
            if (bid >= nb - 2) { const int w_ = opaque_tid() >> 6; for (int bh = (bid - (nb - 2)) * 8 + w_; bh < 16; bh += 16) fscan_wave(P, lds, bh); }
            { const int nun = (M / 256) * (NZ / 256), umax = (nun + nb - 1) / nb, first_short = nun - (umax - 1) * nb;
              if (l + 1 < DEPTH && first_short < nb && bid >= first_short) { __syncthreads(); ada_layer(P, lds, l + 1, bid - first_short, nb - first_short); }
              else if (l + 1 < DEPTH && first_short >= nb) { __syncthreads(); ada_layer(P, lds, l + 1, bid, nb); } }
            SEAM(pb + 1); }
        if (IN(pb + 2)) { PL; unsigned* ctl_ = WSP(unsigned, WS_CTL); ph_selfmin(P, lds, bid, nb); split_arrive(ctl_ + CW_SPLIT + 64 * l + 32);
            ph_mixprep(P, lds, l, bid, nb); split_arrive(ctl_ + CW_SPLIT + 64 * l); split_wait(ctl_ + CW_SPLIT + 64 * l + 32, (unsigned)nb, ctl_ + CW_BAR + XB_TMO);
            ph_attn(P, lds, l, bid, nb); __syncthreads(); split_wait(ctl_ + CW_SPLIT + 64 * l, (unsigned)nb, ctl_ + CW_BAR + XB_TMO);
            for (int u = bid; u < 256; u += nb) lru_fixup_tile(P, lds, u); SEAM(pb + 2); }
        if (IN(pb + 3)) { PL; ph_attn_combine(P, lds, bid, nb); SEAM(pb + 3); }
        if (IN(pb + 4)) { PL; const float* modl = WSP(float, WS_MOD) + (size_t)l * 2 * NADA; pg8::Gemm g{WSP(bf16_t, WS_Y), WSP(bf16_t, WS_WOUT) + (size_t)l * DM * DM, M, DM, DM}; pg8::StaticOrder S; S.init(M, DM, nb, bid);
            pg8::EpiResid<false> E{P.x_in, WSP(const _Float16, WS_XH), WSP(_Float16, WS_XH), modl + 2 * DM};
            pg8::gemm_phase<pg8::EpiResid<false>, pg8::StaticOrder, true, true>(lds3, g, S, E); SEAM(pb + 4); }
        if (IN(pb + 5)) { PL; ph_norm<1, false>(P, lds, l, bid, nb); SEAM(pb + 5); }
        if (IN(pb + 6)) { PL; pg8::Gemm g{WSP(bf16_t, WS_H), WSP(bf16_t, WS_WGU) + (size_t)l * NGU * DM, M, NGU, DM}; pg8::StaticOrder S; S.init(M, NGU, nb, bid);
            pg8::EpiGUAct E{WSP(bf16_t, WS_ACT), P.ffn_cw + (size_t)l * 3 * DFF, P.ffn_cb + l * DFF, WSP(float, WS_SIDE), (PG8_LAS float*)(lds3 + LDS_HALO)};
            pg8::gemm_phase<pg8::EpiGUAct, pg8::StaticOrder, true, true>(lds3, g, S, E); SEAM(pb + 6); }
        if (IN(pb + 7)) { PL; const float* modl = WSP(float, WS_MOD) + (size_t)l * 2 * NADA; pg8::Gemm g{WSP(bf16_t, WS_ACT), WSP(bf16_t, WS_WDN) + (size_t)l * DM * DFF, M, DM, DFF}; pg8::StaticOrder S; S.init(M, DM, nb, bid);
            { pg8::StaticOrder Sf; Sf.init(M, DM, nb, bid); pg8::Unit u0, u1; const bool h0 = Sf.next(0, u0), h1 = Sf.next(1, u1);
              if (nb * 2 >= (M / 256) * (DM / 256)) { if (h0) ffn_fix_tile(P, l, u0.pm); if (h1 && u1.pm != u0.pm) ffn_fix_tile(P, l, u1.pm); }
              else { for (int t = 0; t < M / 256; ++t) ffn_fix_tile(P, l, t); }
              asm volatile("s_waitcnt vmcnt(0)" ::: "memory"); __syncthreads(); }
            pg8::EpiResid<false> E{P.x_in, WSP(const _Float16, WS_XH), WSP(_Float16, WS_XH), modl + 5 * DM};
            pg8::gemm_phase<pg8::EpiResid<false>, pg8::StaticOrder, true, true>(lds3, g, S, E); SEAM(pb + 7); }
        }
    if (IN(NPH - 1)) { PL; ph_finalnorm(P, bid, nb); }
#undef IN
#undef SEAM
#undef PL
}

extern "C" void kernel_launch(void* const* d_in, const int* in_sizes, int n_in, void* d_out, int out_size, void* d_ws, size_t ws_size, hipStream_t stream) {
    static int grid = 0;
    if (grid == 0) {
        if (n_in != 24 || out_size != M * DM || ws_size < WS_END) { fprintf(stderr, "kernel_launch: unexpected shapes (n_in %d out %d ws %zu)\n", n_in, out_size, ws_size); grid = -1; return; }
        int dev = 0, cus = 0;
        if (hipGetDevice(&dev) != hipSuccess || hipDeviceGetAttribute(&cus, hipDeviceAttributeMultiprocessorCount, dev) != hipSuccess || cus <= 0) cus = 256;
        if (hipFuncSetAttribute((const void*)fox_fwd, hipFuncAttributeMaxDynamicSharedMemorySize, LDS_TOTAL) != hipSuccess) { fprintf(stderr, "kernel_launch: hipFuncSetAttribute failed\n"); grid = -1; return; }
        (void)hipGetLastError();
        grid = cus < 256 ? cus : 256;
    }
    if (grid < 0) return;
    static_assert((CW_NRM + DEPTH * 128) * 4 <= 65536 && (CW_SPLIT + 64 * DEPTH) * 4 <= 65536 && (CW_BAR + XCD_BAR_WORDS) * 4 <= 65536, "control words inside the zeroed 64 KiB");
    (void)hipMemsetAsync((char*)d_ws + WS_CTL, 0, 65536, stream);
    Params p; memset(&p, 0, sizeof(p));
    const float* const* in = (const float* const*)d_in;
    p.x_in = in[0]; p.c = in[1]; p.w_ada = in[2]; p.b_ada = in[3]; p.g_mix = in[4]; p.w_in = in[5]; p.b_f = in[6]; p.pool_w = in[7]; p.pool_scale = in[8];
    p.lru_cw = in[9]; p.lru_cb = in[10]; p.lru_wa = in[11]; p.lru_ba = in[12]; p.lru_wi = in[13]; p.lru_bi = in[14]; p.lru_lam = in[15]; p.w_out = in[16]; p.g_ffn = in[17];
    p.w_gate = in[18]; p.w_up = in[19]; p.ffn_cw = in[20]; p.ffn_cb = in[21]; p.w_down = in[22]; p.final_g = in[23];
    p.out = (float*)d_out; p.ws = (unsigned char*)d_ws;
#if ONE_LAUNCH
    fox_fwd<<<grid, NTHR, LDS_TOTAL, stream>>>(p, 0, NPH);
#else
    for (int k = 0; k < NPH; ++k) fox_fwd<<<grid, NTHR, LDS_TOTAL, stream>>>(p, k, k + 1);
#endif
}
```

```cpp
#include <hip/hip_runtime.h>
#include <cstdio>
#include <cstdint>

typedef unsigned short bf16_t;
typedef short bf16x8 __attribute__((ext_vector_type(8)));
typedef float f32x4 __attribute__((ext_vector_type(4)));

constexpr int SEQ = 8192, DM = 2048, DEPTH = 4, M = 2 * SEQ;
constexpr int PW = 512, LW = 512, DFF = 5632, NIN = 4616, NZ = 4608, NGU = 2 * DFF;
constexpr int NADA = 6 * DM;

constexpr size_t MiB = (size_t)1 << 20;
constexpr size_t WS_CTL = 0, WS_MOD = 1 * MiB, WS_WIN = 8 * MiB, WS_WOUT = 80 * MiB, WS_WGU = 112 * MiB, WS_WDN = 288 * MiB, WS_WSM = 376 * MiB;
constexpr size_t WS_H = 378 * MiB, WS_Q = 442 * MiB, WS_K = 474 * MiB, WS_V = 506 * MiB, WS_ZP = 538 * MiB, WS_ZX = 554 * MiB, WS_ZY = 570 * MiB;
constexpr size_t WS_FL = 586 * MiB, WS_F = 587 * MiB, WS_Y = 588 * MiB, WS_ACT = 652 * MiB, WS_LRUA = 828 * MiB, WS_LRUB = 860 * MiB;
constexpr size_t WS_XC = 908 * MiB, WS_SCR = 988 * MiB, WS_END = 1372 * MiB;

__device__ __forceinline__ bf16_t f2bf(float f) { unsigned u = __float_as_uint(f); return (bf16_t)((u + 0x7fffu + ((u >> 16) & 1u)) >> 16); }
__device__ __forceinline__ float log_sigmoidf_(float x) { return fminf(x, 0.f) - log1pf(expf(-fabsf(x))); }

#include <cstring>
__device__ __forceinline__ int opaque_tid() { int t = threadIdx.x; asm volatile("" : "+v"(t)); return t; }

namespace pg8 {
#define PG8_LAS __attribute__((address_space(3)))
typedef unsigned short bf16_t;
typedef short bf16x8 __attribute__((ext_vector_type(8)));
typedef float f32x4 __attribute__((ext_vector_type(4)));
typedef unsigned u32x4 __attribute__((ext_vector_type(4)));
constexpr int BM = 256, BK = 64, HALF = 128, HTB = HALF * BK * 2  , STAGE_BYTES = 8 * HTB, NXCD = 8, WGM = 8;

__host__ __device__ __forceinline__ int lds_byte(int r, int c) { const int st = (r >> 4) * 2 + (c >> 5), rr = r & 15, cc = c & 31, ob = rr * 64 + cc * 2; return st * 1024 + (ob ^ (((ob >> 9) & 1) << 5)); }
__host__ __device__ __forceinline__ void stage_rc(int b, int& R, int& C) { const int st = b / 1024, sb = b % 1024, swz = sb ^ (((sb >> 9) & 1) << 5); R = (st >> 1) * 16 + swz / 64; C = (st & 1) * 32 + (swz % 64) / 2; }
__host__ __device__ __forceinline__ int perm32(int rho) { const int n = rho >> 4, i = rho & 15; return 8 * (i >> 2) + 4 * n + (i & 3); }

struct Unit { int pm, pn; };
struct Gemm { const bf16_t* A; const bf16_t* Bt; int M, N, K; };

struct StaticOrder {
    int nM, nN, nwg, G, c;
    __host__ __device__ __forceinline__ void init(int M, int N, int G_, int c_) { nM = M / BM; nN = N / BM; nwg = nM * nN; G = G_; c = c_; }
    __host__ __device__ __forceinline__ bool next(int i, Unit& u) const {
        const long L = (long)i * G + c; if (L >= nwg) return false;
        int wgid = (int)L; { const int q = nwg / NXCD, r = nwg % NXCD, xcd = wgid % NXCD, off = wgid / NXCD; wgid = (xcd < r ? xcd * (q + 1) : r * (q + 1) + (xcd - r) * q) + off; }
        const int nig = WGM * nN, gid = wgid / nig, fm = gid * WGM, gsz = (nM - fm) < WGM ? (nM - fm) : WGM;
        u.pm = fm + ((wgid % nig) % gsz); u.pn = (wgid % nig) / gsz; return true;
    }
    __device__ __forceinline__ void a_ready(const Unit&) const {}
    __device__ __forceinline__ void done(const Unit&) const {}
};

__device__ __forceinline__ unsigned cvt_pk_bf16(float lo, float hi) { unsigned r; asm volatile("v_cvt_pk_bf16_f32 %0, %1, %2" : "=v"(r) : "v"(lo), "v"(hi)); return r; }


struct EpiZr {
    static constexpr bool PERM = true, AFTER_DRAIN = false;
    static constexpr size_t QKV_STRIDE = (size_t)16 << 20;
    bf16_t *zp, *q, *zx, *zy; unsigned* nrm; PG8_LAS float* nrmp;
    __device__ __forceinline__ void operator()(const f32x4 (&acc)[2][2][4][2], const Unit& u, int wr, int wc, int fr, int fq) const {
        const int r0 = u.pm * BM, bb = r0 >> 13, s0 = r0 & 8191;
#pragma unroll
        for (int bj = 0; bj < 2; ++bj) {
            const int cb = u.pn * 2 + bj; bf16_t* base; int stride;
            if (cb < 4) { base = zp + (size_t)r0 * 512 + cb * 128; stride = 512; }
            else if (cb < 28) { const int t = (cb - 4) >> 3, hh = (cb - 4) & 7; base = q + (size_t)t * QKV_STRIDE + ((size_t)(bb * 8 + hh) * 8192 + s0) * 128; stride = 128; }
            else if (cb < 32) { base = zx + (size_t)r0 * 512 + (cb - 28) * 128; stride = 512; }
            else { base = zy + (size_t)r0 * 512 + (cb - 32) * 128; stride = 512; }
            base += wc * 32 + 8 * fq;
#pragma unroll
            for (int ai = 0; ai < 2; ++ai)
#pragma unroll
                for (int m = 0; m < 4; ++m) { const int lr = ai * HALF + wr * 64 + m * 16 + fr; const f32x4 v0 = acc[ai][bj][m][0], v1 = acc[ai][bj][m][1];
                    u32x4 w; w.x = cvt_pk_bf16(v0[0], v0[1]); w.y = cvt_pk_bf16(v0[2], v0[3]); w.z = cvt_pk_bf16(v1[0], v1[1]); w.w = cvt_pk_bf16(v1[2], v1[3]);
                    *(u32x4*)(base + (size_t)lr * stride) = w; }
            if (cb >= 4 && cb < 20) {
#pragma unroll
                for (int ai = 0; ai < 2; ++ai)
#pragma unroll
                    for (int m = 0; m < 4; ++m) { const f32x4 v0 = acc[ai][bj][m][0], v1 = acc[ai][bj][m][1];
                        float ss = (v0[0] * v0[0] + v0[1] * v0[1]) + (v0[2] * v0[2] + v0[3] * v0[3]) + (v1[0] * v1[0] + v1[1] * v1[1]) + (v1[2] * v1[2] + v1[3] * v1[3]);
                        ss += __builtin_bit_cast(float, __builtin_amdgcn_ds_swizzle(__builtin_bit_cast(int, ss), 0x401f));
                        { const auto rr = __builtin_amdgcn_permlane32_swap(__builtin_bit_cast(unsigned, ss), __builtin_bit_cast(unsigned, ss), false, false); ss = __builtin_bit_cast(float, rr[0]) + __builtin_bit_cast(float, rr[1]); }
                        if (fq == 0) nrmp[bj * 1024 + (ai * HALF + wr * 64 + m * 16 + fr) * 4 + wc] = ss; }
            }
        }
        if (u.pn >= 2 && u.pn < 10) {
            asm volatile("s_waitcnt lgkmcnt(0)" ::: "memory"); __builtin_amdgcn_s_barrier(); asm volatile("" ::: "memory");
            const int t_ = (wr * 4 + wc) * 64 + fq * 16 + fr; const f32x4 p4 = *(const PG8_LAS f32x4*)(nrmp + t_ * 4);
            float mx = (p4[0] + p4[1]) + (p4[2] + p4[3]);
            mx = fmaxf(mx, __builtin_bit_cast(float, __builtin_amdgcn_ds_swizzle(__builtin_bit_cast(int, mx), 0x041f)));
            mx = fmaxf(mx, __builtin_bit_cast(float, __builtin_amdgcn_ds_swizzle(__builtin_bit_cast(int, mx), 0x081f)));
            mx = fmaxf(mx, __builtin_bit_cast(float, __builtin_amdgcn_ds_swizzle(__builtin_bit_cast(int, mx), 0x101f)));
            mx = fmaxf(mx, __builtin_bit_cast(float, __builtin_amdgcn_ds_swizzle(__builtin_bit_cast(int, mx), 0x201f)));
            mx = fmaxf(mx, __builtin_bit_cast(float, __builtin_amdgcn_ds_swizzle(__builtin_bit_cast(int, mx), 0x401f)));
            { const auto rr = __builtin_amdgcn_permlane32_swap(__builtin_bit_cast(unsigned, mx), __builtin_bit_cast(unsigned, mx), false, false); mx = fmaxf(__builtin_bit_cast(float, rr[0]), __builtin_bit_cast(float, rr[1])); }
            if (fr == 0 && fq == 0) { const int cb = u.pn * 2 + wr  , t = (cb - 4) >> 3, hh = (cb - 4) & 7; atomicMax(nrm + ((bb * 8 + hh) * 2 + t) * 4, __builtin_bit_cast(unsigned, mx)); }
        }
    }
};
template <int N> __device__ __forceinline__ float conv_prev(float oldv, float cur) {
    return __builtin_bit_cast(float, __builtin_amdgcn_update_dpp(__builtin_bit_cast(int, oldv), __builtin_bit_cast(int, cur), 0x110 + N, 0xf, 0xf, false));
}
template <int N> __device__ __forceinline__ float row_ror(float v) { return __builtin_bit_cast(float, __builtin_amdgcn_update_dpp(0, __builtin_bit_cast(int, v), 0x120 + N, 0xf, 0xf, false)); }
typedef float f32x2 __attribute__((ext_vector_type(2)));
template <int N> __device__ __forceinline__ float gu_ror(float v) { return __builtin_bit_cast(float, __builtin_amdgcn_mov_dpp(__builtin_bit_cast(int, v), 0x120 + N, 0xf, 0xf, true)); }
struct EpiGUAct {
    static constexpr bool PERM = true, AFTER_DRAIN = false;
    bf16_t* act; const float* cw; const float* cb; float* side; PG8_LAS float* halo;
    __device__ __forceinline__ void operator()(const f32x4 (&acc)[2][2][4][2], const Unit& u, int wr, int wc, int fr, int fq) const {
        const int ch0 = u.pn * 128 + wc * 32 + 8 * fq, lc0 = wc * 32 + 8 * fq;
        f32x4 w0[2], w1[2], w2[2], bb[2];
#pragma unroll
        for (int n = 0; n < 2; ++n) { w0[n] = *(const f32x4*)(cw + ch0 + 4 * n); w1[n] = *(const f32x4*)(cw + 5632 + ch0 + 4 * n); w2[n] = *(const f32x4*)(cw + 2 * 5632 + ch0 + 4 * n); bb[n] = *(const f32x4*)(cb + ch0 + 4 * n); }
        if (fr >= 14) {
#pragma unroll
            for (int ai = 0; ai < 2; ++ai) { PG8_LAS float* hp = halo + ((2 * ai + wr) * 2 + (fr - 14)) * 128 + lc0; *(PG8_LAS f32x4*)hp = acc[ai][0][3][0]; *(PG8_LAS f32x4*)(hp + 4) = acc[ai][0][3][1]; }
        }
        asm volatile("s_waitcnt lgkmcnt(0)" ::: "memory"); __builtin_amdgcn_s_barrier(); asm volatile("" ::: "memory");
        const bool ge1 = fr >= 1, ge2 = fr >= 2;
#pragma unroll
        for (int ai = 0; ai < 2; ++ai) {
            const int s = 2 * ai + wr; f32x4 o1[2], o2[2];
            if (s > 0) { const PG8_LAS float* hp = halo + ((s - 1) * 2) * 128 + lc0;
#pragma unroll
                for (int n = 0; n < 2; ++n) { const f32x4 r62 = *(const PG8_LAS f32x4*)(hp + 4 * n), r63 = *(const PG8_LAS f32x4*)(hp + 128 + 4 * n); o1[n] = r63; o2[n] = fr == 0 ? r62 : r63; } }
            else { o1[0] = o1[1] = o2[0] = o2[1] = (f32x4){0.f, 0.f, 0.f, 0.f}; }
#pragma unroll
            for (int m = 0; m < 4; ++m) { unsigned pk[4];
#pragma unroll
                for (int n = 0; n < 2; ++n) { const f32x4 cur = acc[ai][0][m][n], up = acc[ai][1][m][n]; float a[4];
#pragma unroll
                    for (int e = 0; e < 4; e += 2) {
                        const f32x2 c2 = {cur[e], cur[e + 1]}, r1 = {gu_ror<1>(cur[e]), gu_ror<1>(cur[e + 1])}, r2 = {gu_ror<2>(cur[e]), gu_ror<2>(cur[e + 1])};
                        const f32x2 p1 = {ge1 ? r1[0] : o1[n][e], ge1 ? r1[1] : o1[n][e + 1]}, p2 = {ge2 ? r2[0] : o2[n][e], ge2 ? r2[1] : o2[n][e + 1]};
                        const f32x2 w0v = {w0[n][e], w0[n][e + 1]}, w1v = {w1[n][e], w1[n][e + 1]}, w2v = {w2[n][e], w2[n][e + 1]}, bbv = {bb[n][e], bb[n][e + 1]}, u2 = {up[e], up[e + 1]};
                        const f32x2 g = __builtin_elementwise_fma(w0v, p2, __builtin_elementwise_fma(w1v, p1, __builtin_elementwise_fma(w2v, c2, bbv)));
                        const f32x2 t = g * -1.4426950408889634f; const f32x2 d = (f32x2){__builtin_amdgcn_exp2f(t[0]), __builtin_amdgcn_exp2f(t[1])} + 1.f;
                        const f32x2 sg = {__builtin_amdgcn_rcpf(d[0]), __builtin_amdgcn_rcpf(d[1])}; const f32x2 av = g * sg * u2;
                        a[e] = av[0]; a[e + 1] = av[1];
                        o1[n][e] = r1[0]; o1[n][e + 1] = r1[1]; o2[n][e] = r2[0]; o2[n][e + 1] = r2[1]; }
                    pk[2 * n] = cvt_pk_bf16(a[0], a[1]); pk[2 * n + 1] = cvt_pk_bf16(a[2], a[3]); }
                if (!(s == 0 && m == 0 && fr < 2)) *(u32x4*)(act + (size_t)(u.pm * BM + ai * HALF + wr * 64 + m * 16 + fr) * 5632 + ch0) = (u32x4){pk[0], pk[1], pk[2], pk[3]}; }
        }
        if (fr >= 14 && wr == 1) { float* sp = side + ((size_t)u.pm * 6 + 4 + (fr - 14)) * 5632 + ch0; *(f32x4*)sp = acc[1][0][3][0]; *(f32x4*)(sp + 4) = acc[1][0][3][1]; }
        if (wr == 0 && fr < 2) { float* sp = side + ((size_t)u.pm * 6 + fr) * 5632 + ch0; *(f32x4*)sp = acc[0][0][0][0]; *(f32x4*)(sp + 4) = acc[0][0][0][1];
            sp += 2 * 5632; *(f32x4*)sp = acc[0][1][0][0]; *(f32x4*)(sp + 4) = acc[0][1][0][1]; }
    }
};
typedef _Float16 h16x4 __attribute__((ext_vector_type(4)));
typedef _Float16 h16x8 __attribute__((ext_vector_type(8)));
__device__ __forceinline__ f32x4 ldh4(const _Float16* p) { const h16x4 h = *(const h16x4*)p; return __builtin_convertvector(h, f32x4); }
__device__ __forceinline__ void sth4(_Float16* p, f32x4 v) { *(h16x4*)p = __builtin_convertvector(v, h16x4); }
template <bool XF32>
struct EpiResid {
    static constexpr bool PERM = true, AFTER_DRAIN = false;
    const float* xin; const _Float16* xh; _Float16* xout; const float* gate;
    __device__ __forceinline__ void operator()(const f32x4 (&acc)[2][2][4][2], const Unit& u, int wr, int wc, int fr, int fq) const {
        const int col0 = u.pn * BM + wc * 32 + 8 * fq; const float* gp = gate + ((u.pm * BM) >> 13) * 12288 + col0;
        f32x4 gv[2][2];
#pragma unroll
        for (int bj = 0; bj < 2; ++bj)
#pragma unroll
            for (int n = 0; n < 2; ++n) gv[bj][n] = *(const f32x4*)(gp + bj * HALF + n * 4);
        const unsigned row0 = u.pm * BM + wr * 64 + fr;
        if constexpr (XF32) {
#pragma unroll
            for (int ai = 0; ai < 2; ++ai)
#pragma unroll
                for (int m = 0; m < 4; ++m) { const size_t off = (size_t)(row0 + ai * HALF + m * 16) * 2048 + col0;
#pragma unroll
                    for (int bj = 0; bj < 2; ++bj) { const f32x4 x0 = *(const f32x4*)(xin + off + bj * HALF), x1 = *(const f32x4*)(xin + off + bj * HALF + 4);
                        const h16x4 r0 = __builtin_convertvector(x0 + gv[bj][0] * acc[ai][bj][m][0], h16x4), r1 = __builtin_convertvector(x1 + gv[bj][1] * acc[ai][bj][m][1], h16x4);
                        *(h16x8*)(xout + off + bj * HALF) = __builtin_shufflevector(r0, r1, 0, 1, 2, 3, 4, 5, 6, 7); }
                    if (m == 3) asm volatile("" ::: "memory"); }
        } else {
            h16x8 xr[2][4][2];
#pragma unroll
            for (int ai = 0; ai < 2; ++ai)
#pragma unroll
                for (int m = 0; m < 4; ++m) { const size_t off = (size_t)(row0 + ai * HALF + m * 16) * 2048 + col0;
#pragma unroll
                    for (int bj = 0; bj < 2; ++bj) xr[ai][m][bj] = *(const h16x8*)(xh + off + bj * HALF); }
            asm volatile("" ::: "memory");
#pragma unroll
            for (int ai = 0; ai < 2; ++ai)
#pragma unroll
                for (int m = 0; m < 4; ++m) { const size_t off = (size_t)(row0 + ai * HALF + m * 16) * 2048 + col0;
#pragma unroll
                    for (int bj = 0; bj < 2; ++bj) { const h16x8 xv = xr[ai][m][bj];
                        const f32x4 x0 = __builtin_convertvector(__builtin_shufflevector(xv, xv, 0, 1, 2, 3), f32x4), x1 = __builtin_convertvector(__builtin_shufflevector(xv, xv, 4, 5, 6, 7), f32x4);
                        const h16x4 r0 = __builtin_convertvector(x0 + gv[bj][0] * acc[ai][bj][m][0], h16x4), r1 = __builtin_convertvector(x1 + gv[bj][1] * acc[ai][bj][m][1], h16x4);
                        *(h16x8*)(xout + off + bj * HALF) = __builtin_shufflevector(r0, r1, 0, 1, 2, 3, 4, 5, 6, 7); } }
        }
    }
};

template <class Epi, class Sched, bool ALIGN_EPI = false, bool SP2 = false>
__device__ __forceinline__ void gemm_phase(PG8_LAS unsigned char* lds, const Gemm g, const Sched& S, const Epi& E) {
    const int tid = opaque_tid(), wid = __builtin_amdgcn_readfirstlane(tid >> 6), lane = tid & 63, wr = wid >> 2, wc = wid & 3, fr = lane & 15, fq = lane >> 4;
    const int K = g.K, nt = K / BK;
    unsigned voffA[2], voffB[2];
#pragma unroll
    for (int i = 0; i < 2; ++i) { int R, C; stage_rc(tid * 16 + i * 8192, R, C); const int Rb = Epi::PERM ? ((R & ~31) + perm32(R & 31)) : R;
        voffA[i] = (unsigned)(R * K + C) * 2u; voffB[i] = (unsigned)(Rb * K + C) * 2u; }
    const size_t kstep = (size_t)(BK * 2);
    const size_t hstep = (size_t)HALF * K * 2;
    const size_t tstep = 2 * hstep;
    const unsigned ldsw = (unsigned)wid * 1024u;
    const int aoff = lds_byte(wr * 64 + fr, fq * 8), boff = lds_byte(wc * 32 + fr, fq * 8);
#define PG8_SA(b, h) (((b) * 2 + (h)) * HTB)
#define PG8_SB(b, h) ((4 + (b) * 2 + (h)) * HTB)
#define PG8_STAGE(bufoff, gbase, voff) do { _Pragma("unroll") for (int _i = 0; _i < 2; ++_i) \
        __builtin_amdgcn_global_load_lds((const unsigned*)((const char*)(gbase) + (voff)[_i]), (PG8_LAS unsigned*)(lds + (bufoff) + ldsw + _i * 8192), 16, 0, 0); } while (0)
#define PG8_LDA(dst, b, h) do { _Pragma("unroll") for (int m = 0; m < 4; ++m) _Pragma("unroll") for (int k = 0; k < 2; ++k) dst[m][k] = *(const PG8_LAS bf16x8*)(lds + PG8_SA(b, h) + aoff + m * 2048 + k * 1024); } while (0)
#define PG8_LDB(dst, b, h) do { _Pragma("unroll") for (int n = 0; n < 2; ++n) _Pragma("unroll") for (int k = 0; k < 2; ++k) dst[n][k] = *(const PG8_LAS bf16x8*)(lds + PG8_SB(b, h) + boff + n * 2048 + k * 1024); } while (0)
#define PG8_MMA(ai, bj, At, Bt) do { __builtin_amdgcn_s_setprio(1); _Pragma("unroll") for (int m = 0; m < 4; ++m) _Pragma("unroll") for (int n = 0; n < 2; ++n) _Pragma("unroll") for (int k = 0; k < 2; ++k) \
        acc[ai][bj][m][n] = __builtin_amdgcn_mfma_f32_16x16x32_bf16(Bt[n][k], At[m][k], acc[ai][bj][m][n], 0, 0, 0); __builtin_amdgcn_s_setprio(0); } while (0)
#define PG8_WAIT_V(n) asm volatile("s_waitcnt vmcnt(" #n ")" ::: "memory")
#define PG8_WAIT_L(n) asm volatile("s_waitcnt lgkmcnt(" #n ")" ::: "memory")
#define PG8_BAR __builtin_amdgcn_s_barrier()
#define PG8_SCHED __builtin_amdgcn_sched_barrier(0)
    Unit cur, nxt; int ui = 0;
    if (!S.next(0, cur)) return;
    f32x4 acc[2][2][4][2];
#pragma unroll
    for (int a = 0; a < 2; ++a)
#pragma unroll
        for (int b = 0; b < 2; ++b)
#pragma unroll
            for (int m = 0; m < 4; ++m)
#pragma unroll
                for (int n = 0; n < 2; ++n) acc[a][b][m][n] = (f32x4){0.f, 0.f, 0.f, 0.f};
    bf16x8 At[4][2], B0[2][2], B1[2][2];
    const char* cA = (const char*)g.A + (size_t)cur.pm * tstep; const char* cB = (const char*)g.Bt + (size_t)cur.pn * tstep;
    S.a_ready(cur);
    if constexpr (SP2) {
        PG8_STAGE(PG8_SB(0, 0), cB, voffB); PG8_STAGE(PG8_SB(0, 1), cB + hstep, voffB); PG8_STAGE(PG8_SA(0, 0), cA, voffA); PG8_STAGE(PG8_SA(0, 1), cA + hstep, voffA);
        if (wr == 1) PG8_BAR;
        PG8_WAIT_V(2); PG8_BAR;
        PG8_STAGE(PG8_SB(1, 0), cB + kstep, voffB); PG8_STAGE(PG8_SA(1, 0), cA + kstep, voffA); PG8_STAGE(PG8_SB(1, 1), cB + hstep + kstep, voffB);
        PG8_WAIT_V(6); PG8_BAR;
    } else {
        PG8_STAGE(PG8_SB(0, 0), cB, voffB); PG8_STAGE(PG8_SA(0, 0), cA, voffA); PG8_STAGE(PG8_SB(0, 1), cB + hstep, voffB); PG8_STAGE(PG8_SA(0, 1), cA + hstep, voffA);
        if (wr == 1) PG8_BAR;
        PG8_WAIT_V(4); PG8_BAR;
        PG8_STAGE(PG8_SB(1, 0), cB + kstep, voffB); PG8_STAGE(PG8_SA(1, 0), cA + kstep, voffA); PG8_STAGE(PG8_SB(1, 1), cB + hstep + kstep, voffB);
        PG8_WAIT_V(6); PG8_BAR;
    }
    for (;;) {
        const bool has_next = S.next(ui + 1, nxt);
        const char* nA = has_next ? (const char*)g.A + (size_t)nxt.pm * tstep : cA; const char* nB = has_next ? (const char*)g.Bt + (size_t)nxt.pn * tstep : cB;
        for (int t = 0; t < nt; t += 2) {
            const bool last = (t == nt - 2);
            const char* a1 = cA + (size_t)(t + 1) * kstep;
            const char* a2 = last ? nA : cA + (size_t)(t + 2) * kstep; const char* b2 = last ? nB : cB + (size_t)(t + 2) * kstep;
            const char* a3 = a2 + kstep; const char* b3 = b2 + kstep;
            if (last && has_next) S.a_ready(nxt);
            if constexpr (SP2) {
            PG8_LDB(B0, 0, 0); PG8_LDB(B1, 0, 1); PG8_SCHED; PG8_LDA(At, 0, 0); PG8_STAGE(PG8_SA(1, 1), a1 + hstep, voffA);
            PG8_WAIT_V(8); PG8_WAIT_L(0); PG8_BAR; PG8_MMA(0, 0, At, B0); PG8_MMA(0, 1, At, B1); PG8_BAR; PG8_SCHED;
            PG8_LDA(At, 0, 1); PG8_STAGE(PG8_SB(0, 0), b2, voffB); PG8_STAGE(PG8_SB(0, 1), b2 + hstep, voffB); PG8_STAGE(PG8_SA(0, 0), a2, voffA);
            PG8_WAIT_V(8); PG8_WAIT_L(0); PG8_BAR; PG8_MMA(1, 0, At, B0); PG8_MMA(1, 1, At, B1); PG8_BAR; PG8_SCHED;
            PG8_LDB(B0, 1, 0); PG8_LDB(B1, 1, 1); PG8_SCHED; PG8_LDA(At, 1, 0); PG8_STAGE(PG8_SA(0, 1), a2 + hstep, voffA);
            PG8_WAIT_V(8); PG8_WAIT_L(0); PG8_BAR; PG8_MMA(0, 0, At, B0); PG8_MMA(0, 1, At, B1); PG8_BAR; PG8_SCHED;
            PG8_LDA(At, 1, 1); PG8_STAGE(PG8_SB(1, 0), b3, voffB); PG8_STAGE(PG8_SB(1, 1), b3 + hstep, voffB); PG8_STAGE(PG8_SA(1, 0), a3, voffA);
            PG8_WAIT_V(8); PG8_WAIT_L(0); PG8_BAR; PG8_MMA(1, 0, At, B0); PG8_MMA(1, 1, At, B1); PG8_BAR; PG8_SCHED;
            } else {
            PG8_LDB(B0, 0, 0); PG8_SCHED; PG8_LDA(At, 0, 0); PG8_STAGE(PG8_SA(1, 1), a1 + hstep, voffA);
            PG8_WAIT_L(8); PG8_BAR; PG8_WAIT_L(0); PG8_MMA(0, 0, At, B0); PG8_BAR; PG8_SCHED;
            PG8_LDB(B1, 0, 1); PG8_STAGE(PG8_SB(0, 0), b2, voffB);
            PG8_BAR; PG8_WAIT_L(0); PG8_MMA(0, 1, At, B1); PG8_BAR;
            PG8_LDA(At, 0, 1); PG8_STAGE(PG8_SA(0, 0), a2, voffA);
            PG8_BAR; PG8_WAIT_L(0); PG8_MMA(1, 0, At, B0); PG8_BAR; PG8_SCHED;
            PG8_STAGE(PG8_SB(0, 1), b2 + hstep, voffB);
            PG8_WAIT_V(6); PG8_BAR; PG8_MMA(1, 1, At, B1); PG8_BAR;
            PG8_LDB(B0, 1, 0); PG8_SCHED; PG8_LDA(At, 1, 0); PG8_STAGE(PG8_SA(0, 1), a2 + hstep, voffA);
            PG8_WAIT_L(8); PG8_BAR; PG8_WAIT_L(0); PG8_MMA(0, 0, At, B0); PG8_BAR; PG8_SCHED;
            PG8_LDB(B1, 1, 1); PG8_STAGE(PG8_SB(1, 0), b3, voffB);
            PG8_BAR; PG8_WAIT_L(0); PG8_MMA(0, 1, At, B1); PG8_BAR;
            PG8_LDA(At, 1, 1); PG8_STAGE(PG8_SA(1, 0), a3, voffA);
            PG8_BAR; PG8_WAIT_L(0); PG8_MMA(1, 0, At, B0); PG8_BAR; PG8_SCHED;
            PG8_STAGE(PG8_SB(1, 1), b3 + hstep, voffB);
            PG8_WAIT_V(6); PG8_BAR; PG8_MMA(1, 1, At, B1); PG8_BAR;
            }
        }
        if constexpr (ALIGN_EPI) { if (wr == 0) PG8_BAR; }
        if constexpr (!Epi::AFTER_DRAIN) { E(acc, cur, wr, wc, fr, fq); S.done(cur); }
        if (!has_next) break;
#pragma unroll
        for (int a = 0; a < 2; ++a)
#pragma unroll
            for (int b = 0; b < 2; ++b)
#pragma unroll
                for (int m = 0; m < 4; ++m)
#pragma unroll
                    for (int n = 0; n < 2; ++n) acc[a][b][m][n] = (f32x4){0.f, 0.f, 0.f, 0.f};
        cur = nxt; cA = nA; cB = nB; ++ui;
        if constexpr (ALIGN_EPI) { if (wr == 1) PG8_BAR; }
    }
    PG8_WAIT_V(0);
    if constexpr (!ALIGN_EPI) { if (wr == 0) PG8_BAR; }
    PG8_BAR;
    if constexpr (Epi::AFTER_DRAIN) { E.fused(acc, cur, wr, wc, fr, fq, lds, wid, lane); S.done(cur); }
#undef PG8_SA
#undef PG8_SB
#undef PG8_STAGE
#undef PG8_LDA
#undef PG8_LDB
#undef PG8_MMA
#undef PG8_WAIT_V
#undef PG8_WAIT_L
#undef PG8_BAR
#undef PG8_SCHED
}
}

namespace fox {
constexpr int D = 128, LDO = 2048;
constexpr float THR = 8.f; constexpr bool WSKIP = false;
constexpr float SCALE = 0.08838834764831845f, RSCALE = 11.313708498984761f;
constexpr int NW = 8, QBLK = 32, KVBLK = 64, QB = NW * QBLK;
constexpr int SHM_V = KVBLK * D * 2, SHM_K = KVBLK * D * 2;
constexpr int LDS_BIAS = 2 * SHM_V + 2 * SHM_K + NW * 64 * 4;
constexpr int LDS_OSTG = 81920;
typedef unsigned uint4_t __attribute__((ext_vector_type(4)));
constexpr int LDS_BYTES = LDS_BIAS + 2 * 256;
using bf16 = unsigned short;
typedef short bf16x8 __attribute__((ext_vector_type(8)));
typedef short s16x4 __attribute__((ext_vector_type(4)));
typedef float f32x16 __attribute__((ext_vector_type(16)));
typedef float f32x4 __attribute__((ext_vector_type(4)));
typedef unsigned u32x4 __attribute__((ext_vector_type(4)));
template <class A, class Bt> struct same_t { static constexpr bool v = false; };
template <class A> struct same_t<A, A> { static constexpr bool v = true; };

#define KSWZ(row, colB) ((row) * 256 + ((colB) ^ (((row) & 7) << 4)))
#define SBAR() __builtin_amdgcn_sched_barrier(0)
__device__ __forceinline__ int v_st(int k, int c) { const int kk = (k & ~0xC) | ((k & 4) << 1) | ((k & 8) >> 1); return ((kk >> 3) * 4 + (c >> 5)) * 512 + ((kk & 7) * 32 + (c & 31)) * 2; }
__device__ __forceinline__ int v_rd_base(int lane) { return ((lane & 3) << 3) | (((lane >> 2) & 3) << 6) | (((lane >> 4) & 1) << 5) | (((lane >> 5) & 1) << 8); }
constexpr int v_rd_off(int d0, int ks, int half) { return d0 * 512 + ks * 4096 + half * 2048; }
__device__ __forceinline__ int crow(int r, int hi) { return (r & 3) + 8 * (r >> 2) + 4 * hi; }
__device__ __forceinline__ unsigned cvtpk(float lo, float hi) {
    unsigned r; asm volatile("v_cvt_pk_bf16_f32 %0, %1, %2" : "=v"(r) : "v"(lo), "v"(hi)); return r;
}
__device__ __forceinline__ bf16x8 pack8(f32x4 a, f32x4 b) {
    u32x4 w = {cvtpk(a[0], a[1]), cvtpk(a[2], a[3]), cvtpk(b[0], b[1]), cvtpk(b[2], b[3])};
    return *reinterpret_cast<bf16x8*>(&w);
}
template <class T> __device__ __forceinline__ bf16x8 load8(const T* p) {
    if constexpr (same_t<T, float>::v) { return pack8(*(const f32x4*)p, *(const f32x4*)(p + 4)); }
    else { return *reinterpret_cast<const bf16x8*>(p); }
}
__device__ __forceinline__ void mask_tile(f32x16& p0, f32x16& p1, int dq, unsigned W) {
    const float NEG = -__builtin_inff();
#pragma unroll
    for (int r = 0; r < 16; ++r) {
        const int c = (r & 3) + 8 * (r >> 2);
        if ((unsigned)(dq - c) >= W) p0[r] = NEG;
        if ((unsigned)(dq - c - 32) >= W) p1[r] = NEG;
    }
}
__device__ __forceinline__ void partialSM(f32x16& p0, f32x16& p1, float& m_reg, float& mn, float& alpha) {
    float pmax = p0[0]; for (int r = 1; r < 16; ++r) pmax = fmaxf(pmax, p0[r]); for (int r = 0; r < 16; ++r) pmax = fmaxf(pmax, p1[r]);
    { auto rr = __builtin_amdgcn_permlane32_swap(__float_as_uint(pmax), __float_as_uint(pmax), false, false);
      pmax = fmaxf(__uint_as_float(rr[0]), __uint_as_float(rr[1])); }
    constexpr float C2 = 1.4426950408889634f * SCALE;
    if (__builtin_expect(__all((pmax - m_reg) * SCALE <= THR), 1)) { mn = m_reg; alpha = 1.f; }
    else { mn = fmaxf(m_reg, pmax); alpha = __builtin_amdgcn_exp2f((m_reg - mn) * C2); m_reg = mn; }
    const float mnL = -mn * C2;
    for (int r = 0; r < 16; ++r) p0[r] = fmaf(p0[r], C2, mnL); for (int r = 0; r < 16; ++r) p1[r] = fmaf(p1[r], C2, mnL);
    for (int r = 0; r < 16; ++r) p0[r] = __builtin_amdgcn_exp2f(p0[r]);
}
__device__ __forceinline__ void finishSM(f32x16& p0, f32x16& p1, float alpha, float& l_reg, bf16x8& pa0, bf16x8& pa1, bf16x8& pa2, bf16x8& pa3) {
    for (int r = 0; r < 16; ++r) p1[r] = __builtin_amdgcn_exp2f(p1[r]);
    float ps = 0; for (int r = 0; r < 16; ++r) ps += p0[r]; for (int r = 0; r < 16; ++r) ps += p1[r];
    { auto rr = __builtin_amdgcn_permlane32_swap(__float_as_uint(ps), __float_as_uint(ps), false, false);
      ps = __uint_as_float(rr[0]) + __uint_as_float(rr[1]); }
    l_reg = l_reg * alpha + ps;
#define PK4(P, B_, OUT) do { unsigned a0 = cvtpk(P[B_+0], P[B_+1]), a1 = cvtpk(P[B_+2], P[B_+3]);                          \
        unsigned b0 = cvtpk(P[B_+4], P[B_+5]), b1 = cvtpk(P[B_+6], P[B_+7]);                                             \
        auto r0 = __builtin_amdgcn_permlane32_swap(a0, b0, false, false); auto r1 = __builtin_amdgcn_permlane32_swap(a1, b1, false, false); \
        u32x4 w = {r0[0], r1[0], r0[1], r1[1]}; OUT = *reinterpret_cast<bf16x8*>(&w); } while (0)
    PK4(p0, 0, pa0); PK4(p0, 8, pa1); PK4(p1, 0, pa2); PK4(p1, 8, pa3);
#undef PK4
}
template <int KB, bool SK>
__device__ __forceinline__ void qkt(f32x16& p0, f32x16& p1, const char* K_lds, int r32, int hi, const bf16x8* qr, bool act) {
    if (SK && !act) { const float NEG = -__builtin_inff();
#pragma unroll
        for (int r = 0; r < 16; ++r) { p0[r] = NEG; p1[r] = NEG; } return; }
    { const f32x4* bb_ = (const f32x4*)(K_lds + 2 * SHM_K + NW * 64 * 4 + KB * 256) + hi;
#pragma unroll
        for (int g_ = 0; g_ < 4; ++g_) { const f32x4 b0_ = bb_[2 * g_], b1_ = bb_[8 + 2 * g_];
#pragma unroll
            for (int e_ = 0; e_ < 4; ++e_) { p0[4 * g_ + e_] = b0_[e_]; p1[4 * g_ + e_] = b1_[e_]; } } }
    const char* kb[4];
#pragma unroll
    for (int dd = 0; dd < 4; ++dd) kb[dd] = K_lds + KB * SHM_K + KSWZ(r32, (dd * 16 + hi * 8) * 2);
#pragma unroll
    for (int d0 = 0; d0 < 8; ++d0) { const char* a = kb[d0 & 3] + (d0 >> 2) * 128;
        bf16x8 b0 = *reinterpret_cast<const bf16x8*>(a);
        bf16x8 b1 = *reinterpret_cast<const bf16x8*>(a + 32 * 256);
        p0 = __builtin_amdgcn_mfma_f32_32x32x16_bf16(b0, qr[d0], p0, 0, 0, 0);
        p1 = __builtin_amdgcn_mfma_f32_32x32x16_bf16(b1, qr[d0], p1, 0, 0, 0); }
}
template <int VB, bool SK>
__device__ __forceinline__ void pv_tile(f32x16* o, int vb0, bf16x8 pa0, bf16x8 pa1, bf16x8 pa2, bf16x8 pa3, bool act) {
    if (SK && !act) return;
#define TRRD(dst, off) asm volatile("ds_read_b64_tr_b16 %0, %1 offset:%2" : "=&v"(dst) : "v"(vb0), "i"(off) : "memory")
#define PV_D0(d0) do { s16x4 l0, l1, l2, l3, h0, h1, h2, h3; constexpr int b_ = VB * SHM_V + v_rd_off(d0, 0, 0);     \
        TRRD(l0, b_); TRRD(h0, b_ + 2048); TRRD(l1, b_ + 4096); TRRD(h1, b_ + 6144); TRRD(l2, b_ + 8192); TRRD(h2, b_ + 10240); TRRD(l3, b_ + 12288); TRRD(h3, b_ + 14336); \
        asm volatile("s_waitcnt lgkmcnt(0)" ::: "memory"); SBAR();                 \
        o[d0] = __builtin_amdgcn_mfma_f32_32x32x16_bf16(pa0, (bf16x8){l0[0], l0[1], l0[2], l0[3], h0[0], h0[1], h0[2], h0[3]}, o[d0], 0, 0, 0);   \
        o[d0] = __builtin_amdgcn_mfma_f32_32x32x16_bf16(pa1, (bf16x8){l1[0], l1[1], l1[2], l1[3], h1[0], h1[1], h1[2], h1[3]}, o[d0], 0, 0, 0);   \
        o[d0] = __builtin_amdgcn_mfma_f32_32x32x16_bf16(pa2, (bf16x8){l2[0], l2[1], l2[2], l2[3], h2[0], h2[1], h2[2], h2[3]}, o[d0], 0, 0, 0);   \
        o[d0] = __builtin_amdgcn_mfma_f32_32x32x16_bf16(pa3, (bf16x8){l3[0], l3[1], l3[2], l3[3], h3[0], h3[1], h3[2], h3[3]}, o[d0], 0, 0, 0); } while (0)
    PV_D0(0); PV_D0(1); PV_D0(2); PV_D0(3);
#undef PV_D0
#undef TRRD
}

template <class TIn, class TOut> struct BlockRef { const TIn* Q; const TIn* K; const TIn* V; TOut* O; const float* F; float fref; int P0; int jlo, jhi; float* st; };
template <class TIn> struct Seam {
    bf16x8 qr[8];
    bf16x8 st_v0, st_v1, st_k0, st_k1; float st_f; f32x4 sf0, sf1, sf2, sf3;
    f32x4 tq[16];
};
__device__ __forceinline__ int swa_jlo(int P0, int W) { const int lowk = P0 - W + 1; return lowk > 0 ? lowk / KVBLK : 0; }
#define ROW(p, k0, rr) ((decltype(p))((const char*)(p) + (unsigned)((((k0) + (rr)) * D + sc) * (int)sizeof(*(p)))))
#define VMW() asm volatile("s_waitcnt vmcnt(0)" ::: "memory")
#define VMWN(n) asm volatile("s_waitcnt vmcnt(%0)" :: "i"(n) : "memory")
#define SLOAD_H(Kp, Vp, Fp, k0) do { S.st_v0 = load8<TIn>(ROW(Vp, k0, sr)); S.st_v1 = load8<TIn>(ROW(Vp, k0, 32 + sr));              \
                         S.st_k0 = load8<TIn>(ROW(Kp, k0, sr)); S.st_k1 = load8<TIn>(ROW(Kp, k0, 32 + sr)); if (tid < 64) S.st_f = (Fp)[(k0) + tid]; } while (0)
#define SWRITE_HK(bf, fr_) do { *(bf16x8*)(K_lds + (bf) * SHM_K + kws) = S.st_k0; *(bf16x8*)(K_lds + (bf) * SHM_K + kws + 32 * 256) = S.st_k1; \
        if (tid < 64) *(float*)(B_lds + (bf) * 256 + tid * 4) = ((fr_) - S.st_f) * RSCALE; } while (0)
#define SWRITE_HV(bf) do { *(bf16x8*)(V_lds + (bf) * SHM_V + vst0) = S.st_v0; *(bf16x8*)(V_lds + (bf) * SHM_V + vst1) = S.st_v1; } while (0)
#define SWRITE_H(bf) do { SWRITE_HV(bf); SWRITE_HK(bf, cur.fref); } while (0)
#define SLOAD_F(p, k0) do { S.sf0 = *(const f32x4*)ROW(p, k0, sr); S.sf1 = *(const f32x4*)(ROW(p, k0, sr) + 4);                \
                            S.sf2 = *(const f32x4*)ROW(p, k0, 32 + sr); S.sf3 = *(const f32x4*)(ROW(p, k0, 32 + sr) + 4); } while (0)
#define SWRITE_KF(bf) do { *(bf16x8*)(K_lds + (bf) * SHM_K + kws) = pack8(S.sf0, S.sf1); *(bf16x8*)(K_lds + (bf) * SHM_K + kws + 32 * 256) = pack8(S.sf2, S.sf3); } while (0)
#define SWRITE_VF(bf) do { *(bf16x8*)(V_lds + (bf) * SHM_V + vst0) = pack8(S.sf0, S.sf1); *(bf16x8*)(V_lds + (bf) * SHM_V + vst1) = pack8(S.sf2, S.sf3); } while (0)
template <class TIn, class TOut>
__device__ __forceinline__ void causal_swa_prime(const BlockRef<TIn, TOut>& cur, int W, char* lds, Seam<TIn>& S) {
    constexpr bool F32 = same_t<TIn, float>::v;
    const int tid = opaque_tid(), wid = __builtin_amdgcn_readfirstlane(tid >> 6), lane = tid & 63, r32 = lane & 31, hi = lane >> 5;
    const int sr = tid >> 4, sc = (tid & 15) * 8, kws = KSWZ(sr, sc * 2); char* K_lds = lds + 2 * SHM_V; char* B_lds = lds + LDS_BIAS;
    const int kb0 = (cur.jhi - 1) * KVBLK;
    for (int d0 = 0; d0 < 8; ++d0) S.qr[d0] = load8<TIn>(cur.Q + (size_t)(wid * QBLK + r32) * D + d0 * 16 + hi * 8);
    if constexpr (F32) { SLOAD_F((const float*)cur.K, kb0); VMW(); SWRITE_KF(0); SBAR(); SLOAD_F((const float*)cur.V, kb0); }
    else { SLOAD_H(cur.K, cur.V, cur.F, kb0); VMW(); SWRITE_HK(0, cur.fref); }
    __syncthreads();
}
template <class TIn, class TOut>
__device__ __forceinline__ void causal_swa_block(const BlockRef<TIn, TOut>& cur, const BlockRef<TIn, TOut>& nxt, int skv, int W, char* lds, Seam<TIn>& S) {
    constexpr bool F32 = same_t<TIn, float>::v;
    const int tid = opaque_tid(), wid = __builtin_amdgcn_readfirstlane(tid >> 6), lane = tid & 63, r32 = lane & 31, hi = lane >> 5;
    const int j_lo = cur.jlo;
    const int j_hi = cur.jhi;
    const int NT = j_hi - j_lo;
    const int kbn = (nxt.jhi - 1) * KVBLK;
    const int qlo = cur.P0 + wid * QBLK, qm = qlo + r32 - 4 * hi;
    char* V_lds = lds; char* K_lds = lds + 2 * SHM_V; char* B_lds = lds + LDS_BIAS;
    float* ws = (float*)(lds + 2 * SHM_V + 2 * SHM_K) + wid * 64; float* li_l = ws, * al_l = ws + 32;
    float m_reg = -1e30f, l_reg = 0; f32x16 o[4] = {};
    const int sr = tid >> 4, sc = (tid & 15) * 8, vst0 = v_st(sr, sc), vst1 = v_st(32 + sr, sc), kws = KSWZ(sr, sc * 2);
    const int vb0 = (int)(uintptr_t)V_lds + v_rd_base(lane);
    const TIn* Kh = cur.K; const TIn* Vh = cur.V; const float* Fh = cur.F;
#define RESC(a) do { if (__any((a) < 1.f)) { if (hi == 0) al_l[r32] = (a); asm volatile("s_waitcnt lgkmcnt(0)" ::: "memory");              \
                     for (int d_ = 0; d_ < 4; ++d_) for (int r = 0; r < 16; ++r) o[d_][r] *= al_l[crow(r, hi)]; } } while (0)
#define KBASE(t) ((j_hi - 1 - (t)) * KVBLK)
#define ACT(t) (KBASE(t) <= qlo + QBLK - 1 && KBASE(t) + KVBLK - 1 >= qlo - W + 1)
#define MASKT(P0_, P1_, t) do { const int kb_ = KBASE(t); if ((!SK || ACT(t)) && (kb_ + KVBLK - 1 > qlo || kb_ <= qlo + QBLK - 1 - W)) mask_tile(P0_, P1_, qm - kb_, (unsigned)W); } while (0)
#define ADD_BIAS(P0_, P1_, KB_) do { } while (0)
    constexpr int NQL = F32 ? 16 : 8;
    constexpr bool SK = WSKIP && !F32;
#define SEAM_K0() do { VMWN(NQL); if constexpr (F32) { SWRITE_KF(0); SBAR(); SLOAD_F((const float*)nxt.V, kbn); } else { SWRITE_HK(0, nxt.fref); } SBAR(); } while (0)
    f32x16 pA0, pA1, pB0, pB1; float mnA, mnB, alA, alB; bf16x8 pa0, pa1, pa2, pa3;
    if constexpr (F32) { VMW(); SWRITE_VF(0); SBAR(); } else { SWRITE_HV(0); SBAR(); }
    if (NT > 1) { if constexpr (F32) SLOAD_F((const float*)Kh, KBASE(1)); else SLOAD_H(Kh, Vh, Fh, KBASE(1)); }
    SBAR(); qkt<0, SK>(pA0, pA1, K_lds, r32, hi, S.qr, ACT(0));
    if constexpr (F32) { if (NT > 1) { VMW(); SWRITE_KF(1); SBAR(); SLOAD_F((const float*)Vh, KBASE(1)); } }
    ADD_BIAS(pA0, pA1, 0); MASKT(pA0, pA1, 0); partialSM(pA0, pA1, m_reg, mnA, alA);
    if (NT > 1) { VMW(); if constexpr (F32) { SWRITE_VF(1); SBAR(); if (NT > 2) SLOAD_F((const float*)Kh, KBASE(2)); } else SWRITE_H(1); }
    __syncthreads();
#define HALF_STEP(PX0, PX1, mnX, alX, PY0, PY1, alY, t, KB, VB, SB) do {                                                      \
        SBAR(); qkt<KB, SK>(PX0, PX1, K_lds, r32, hi, S.qr, ACT(t));                                             \
        finishSM(PY0, PY1, alY, l_reg, pa0, pa1, pa2, pa3); SBAR();                                                           \
        if ((t) + 1 < NT) { if constexpr (F32) { VMW(); SWRITE_KF(SB); SBAR(); SLOAD_F((const float*)Vh, KBASE((t) + 1)); }  \
                            else { SLOAD_H(Kh, Vh, Fh, KBASE((t) + 1)); } SBAR(); }                                               \
        pv_tile<VB, SK>(o, vb0, pa0, pa1, pa2, pa3, ACT((t) - 1)); ADD_BIAS(PX0, PX1, KB); MASKT(PX0, PX1, (t)); partialSM(PX0, PX1, m_reg, mnX, alX);                                        \
        __syncthreads();                                                                                                      \
        if ((t) + 1 < NT) { VMW(); if constexpr (F32) { SWRITE_VF(SB); SBAR(); if ((t) + 2 < NT) SLOAD_F((const float*)Kh, KBASE((t) + 2)); } \
                            else { SWRITE_H(SB); } }                                                                          \
        RESC(alX); __syncthreads(); } while (0)
    for (int t = 1; t + 1 < NT; t += 2) {
        HALF_STEP(pB0, pB1, mnB, alB, pA0, pA1, alA, t, 1, 0, 0);
        HALF_STEP(pA0, pA1, mnA, alA, pB0, pB1, alB, t + 1, 0, 1, 1);
    }
    const bool even = (NT & 1) == 0;
    if (even) { SBAR(); qkt<1, SK>(pB0, pB1, K_lds, r32, hi, S.qr, ACT(NT - 1)); SBAR(); }
#define QROW(e) (nxt.Q + (size_t)(wid * QBLK + r32) * D + ((e) >> 1) * 16 + hi * 8 + ((e) & 1) * 4)
    if constexpr (F32) { SLOAD_F((const float*)nxt.K, kbn); SBAR();
#pragma unroll
        for (int e = 0; e < 8; ++e) S.tq[e] = *(const f32x4*)QROW(e); }
    else { const TIn* nK_ = nxt.K; const TIn* nV_ = nxt.V; const float* nF_ = nxt.F; const TIn* nQ_ = nxt.Q; asm volatile("" : "+s"(nK_), "+s"(nV_), "+s"(nF_), "+s"(nQ_));
      SLOAD_H(nK_, nV_, nF_, kbn); SBAR();
#pragma unroll
        for (int d0 = 0; d0 < 8; ++d0) S.qr[d0] = load8<TIn>(nQ_ + (size_t)(wid * QBLK + r32) * D + d0 * 16 + hi * 8); }
    SBAR();
    finishSM(pA0, pA1, alA, l_reg, pa0, pa1, pa2, pa3); SBAR();
    if constexpr (F32) {
#pragma unroll
        for (int e = 8; e < 16; ++e) S.tq[e] = *(const f32x4*)QROW(e); SBAR(); }
#undef QROW
    pv_tile<0, SK>(o, vb0, pa0, pa1, pa2, pa3, ACT(even ? NT - 2 : NT - 1));
    if (even) { ADD_BIAS(pB0, pB1, 1); MASKT(pB0, pB1, NT - 1); partialSM(pB0, pB1, m_reg, mnB, alB); __syncthreads(); RESC(alB);
        finishSM(pB0, pB1, alB, l_reg, pa0, pa1, pa2, pa3); SBAR(); pv_tile<1, SK>(o, vb0, pa0, pa1, pa2, pa3, ACT(NT - 1)); }
    SBAR(); SEAM_K0();
    if (cur.st != nullptr) {
        float* sp_ = cur.st; asm volatile("" : "+s"(sp_)); sp_ += (size_t)(wid * 64) * 68 + lane * 4;
#pragma unroll
        for (int d0 = 0; d0 < 4; ++d0)
#pragma unroll
            for (int q4 = 0; q4 < 4; ++q4) *(f32x4*)(sp_ + (d0 * 4 + q4) * 256) = (f32x4){o[d0][q4 * 4], o[d0][q4 * 4 + 1], o[d0][q4 * 4 + 2], o[d0][q4 * 4 + 3]};
        *(f32x4*)(sp_ + 16 * 256) = (f32x4){m_reg, l_reg, 0.f, 0.f};
    } else {
    if (hi == 0) li_l[r32] = l_reg; asm volatile("s_waitcnt lgkmcnt(0)" ::: "memory");
    float rli[16];
#pragma unroll
    for (int r = 0; r < 16; ++r) rli[r] = __builtin_amdgcn_rcpf(li_l[crow(r, hi)]);
    TOut* Ob_ = cur.O; asm volatile("" : "+s"(Ob_)); TOut* Ow = Ob_ + (size_t)(wid * QBLK) * LDO;
    if constexpr (same_t<TOut, float>::v) {
#pragma unroll
        for (int r = 0; r < 16; ++r) { const int orow = crow(r, hi);
#pragma unroll
            for (int d0 = 0; d0 < 4; ++d0) Ow[(size_t)orow * LDO + d0 * 32 + r32] = o[d0][r] * rli[r]; }
    } else {
        char* stg = lds + LDS_OSTG + wid * 4352;
#pragma unroll
        for (int rd = 0; rd < 2; ++rd) {
#pragma unroll
            for (int r8 = 0; r8 < 8; ++r8) { const int r = rd * 8 + r8, lrow = (r8 & 3) + 8 * (r8 >> 2) + 4 * hi;
#pragma unroll
                for (int d0 = 0; d0 < 4; ++d0) { const float v = o[d0][r] * rli[r];
                    const float vn = __builtin_bit_cast(float, __builtin_amdgcn_mov_dpp(__builtin_bit_cast(int, v), 0xB1, 0xF, 0xF, true));
                    if ((r32 & 1) == 0) *(unsigned*)(stg + lrow * 272 + (d0 * 32 + r32) * 2) = cvtpk(v, vn); } }
            asm volatile("s_waitcnt lgkmcnt(0)" ::: "memory");
            uint4_t t4[4];
#pragma unroll
            for (int jj = 0; jj < 4; ++jj) t4[jj] = *(const uint4_t*)(stg + ((lane >> 4) + 4 * jj) * 272 + (lane & 15) * 16);
            asm volatile("s_waitcnt lgkmcnt(0)" ::: "memory");
#pragma unroll
            for (int jj = 0; jj < 4; ++jj) *(uint4_t*)(Ow + (size_t)(rd * 16 + (lane >> 4) + 4 * jj) * LDO + (lane & 15) * 8) = t4[jj];
        }
    }
    }
    if constexpr (F32) {
#pragma unroll
        for (int d0 = 0; d0 < 8; ++d0) S.qr[d0] = pack8(S.tq[2 * d0], S.tq[2 * d0 + 1]); }
    __syncthreads();
#undef RESC
#undef KBASE
#undef ACT
#undef MASKT
#undef ADD_BIAS
#undef SEAM_K0
#undef HALF_STEP
}
#undef ROW
#undef VMW
#undef VMWN
#undef SLOAD_H
#undef SWRITE_HK
#undef SWRITE_HV
#undef SWRITE_H
#undef SLOAD_F
#undef SWRITE_KF
#undef SWRITE_VF


}

#define LAS __attribute__((address_space(3)))
typedef unsigned u32x4 __attribute__((ext_vector_type(4)));
struct Params {
    const float *x_in, *c, *w_ada, *b_ada, *g_mix, *w_in, *b_f, *pool_w, *pool_scale, *lru_cw, *lru_cb, *lru_wa, *lru_ba, *lru_wi, *lru_bi, *lru_lam, *w_out, *g_ffn,
                *w_gate, *w_up, *ffn_cw, *ffn_cb, *w_down, *final_g;
    float* out; unsigned char* ws;
};
constexpr size_t WS_SPT = WS_MOD + 512 * 1024;
constexpr size_t WS_CSA = WS_XC, WS_CSH = WS_XC + 1 * MiB;
constexpr int NTHR = 512, LDS_RING = 131072, LDS_MISC = LDS_RING + 320, LDS_TOTAL = 147456;
constexpr int CW_BAR = 4096;
constexpr int NPH = 2 + 8 * DEPTH;
#define WSP(T, off) ((T*)(P.ws + (off)))
constexpr int LDS_HALO = LDS_RING + 4096;
constexpr int LDS_PTAB = LDS_RING + 1024;
__device__ __forceinline__ const void* ldp(const LAS unsigned* tab, int i) {
    const unsigned lo = __builtin_amdgcn_readfirstlane(tab[2 * i]), hi = __builtin_amdgcn_readfirstlane(tab[2 * i + 1]);
    return (const void*)(const __attribute__((address_space(1))) char*)(((unsigned long long)hi << 32) | lo);
}
__device__ __forceinline__ void stp(LAS unsigned* tab, int i, const void* p) { tab[2 * i] = (unsigned)(unsigned long long)p; tab[2 * i + 1] = (unsigned)((unsigned long long)p >> 32); }
__device__ __forceinline__ void store_params(LAS unsigned* t, const Params& P) {
    stp(t, 0, P.x_in); stp(t, 1, P.c); stp(t, 2, P.w_ada); stp(t, 3, P.b_ada); stp(t, 4, P.g_mix); stp(t, 5, P.w_in); stp(t, 6, P.b_f); stp(t, 7, P.pool_w); stp(t, 8, P.pool_scale);
    stp(t, 9, P.lru_cw); stp(t, 10, P.lru_cb); stp(t, 11, P.lru_wa); stp(t, 12, P.lru_ba); stp(t, 13, P.lru_wi); stp(t, 14, P.lru_bi); stp(t, 15, P.lru_lam); stp(t, 16, P.w_out); stp(t, 17, P.g_ffn);
    stp(t, 18, P.w_gate); stp(t, 19, P.w_up); stp(t, 20, P.ffn_cw); stp(t, 21, P.ffn_cb); stp(t, 22, P.w_down); stp(t, 23, P.final_g); stp(t, 24, P.out); stp(t, 25, P.ws);
}
__device__ __forceinline__ Params load_params(const LAS unsigned* t) {
    Params P;
#define LDF(i) ((const float*)ldp(t, i))
    P.x_in = LDF(0); P.c = LDF(1); P.w_ada = LDF(2); P.b_ada = LDF(3); P.g_mix = LDF(4); P.w_in = LDF(5); P.b_f = LDF(6); P.pool_w = LDF(7); P.pool_scale = LDF(8);
    P.lru_cw = LDF(9); P.lru_cb = LDF(10); P.lru_wa = LDF(11); P.lru_ba = LDF(12); P.lru_wi = LDF(13); P.lru_bi = LDF(14); P.lru_lam = LDF(15); P.w_out = LDF(16); P.g_ffn = LDF(17);
    P.w_gate = LDF(18); P.w_up = LDF(19); P.ffn_cw = LDF(20); P.ffn_cb = LDF(21); P.w_down = LDF(22); P.final_g = LDF(23); P.out = (float*)ldp(t, 24); P.ws = (unsigned char*)ldp(t, 25);
#undef LDF
    return P;
}

__device__ __forceinline__ unsigned pk2bf(float lo, float hi) { typedef float f32x2_ __attribute__((ext_vector_type(2))); typedef __bf16 bf16x2_ __attribute__((ext_vector_type(2)));
    const f32x2_ v = {lo, hi}; return __builtin_bit_cast(unsigned, __builtin_convertvector(v, bf16x2_)); }
__device__ __forceinline__ float bflo(unsigned w) { return __uint_as_float(w << 16); }
__device__ __forceinline__ float bfhi(unsigned w) { return __uint_as_float(w & 0xffff0000u); }
#define UNPACK8(W_, F_) do { const u32x4 w_ = (W_); F_[0] = bflo(w_[0]); F_[1] = bfhi(w_[0]); F_[2] = bflo(w_[1]); F_[3] = bfhi(w_[1]); F_[4] = bflo(w_[2]); F_[5] = bfhi(w_[2]); F_[6] = bflo(w_[3]); F_[7] = bfhi(w_[3]); } while (0)
#define PACK8(F_) ((u32x4){pk2bf(F_[0], F_[1]), pk2bf(F_[2], F_[3]), pk2bf(F_[4], F_[5]), pk2bf(F_[6], F_[7])})

__device__ __forceinline__ float wave_sum(float v) {
    v += __builtin_bit_cast(float, __builtin_amdgcn_ds_swizzle(__builtin_bit_cast(int, v), 0x041f));
    v += __builtin_bit_cast(float, __builtin_amdgcn_ds_swizzle(__builtin_bit_cast(int, v), 0x081f));
    v += __builtin_bit_cast(float, __builtin_amdgcn_ds_swizzle(__builtin_bit_cast(int, v), 0x101f));
    v += __builtin_bit_cast(float, __builtin_amdgcn_ds_swizzle(__builtin_bit_cast(int, v), 0x201f));
    v += __builtin_bit_cast(float, __builtin_amdgcn_ds_swizzle(__builtin_bit_cast(int, v), 0x401f));
    const auto rr = __builtin_amdgcn_permlane32_swap(__float_as_uint(v), __float_as_uint(v), false, false);
    return __uint_as_float(rr[0]) + __uint_as_float(rr[1]);
}
__device__ __forceinline__ float fexp(float x) { return __builtin_amdgcn_exp2f(x * 1.4426950408889634f); }
__device__ __forceinline__ float fsigmoid(float x) { return __builtin_amdgcn_rcpf(1.f + fexp(-x)); }
__device__ __forceinline__ float fgelu_tanh(float x) { const float u = 0.7978845608028654f * (x + 0.044715f * x * x * x); return x * fsigmoid(2.f * u); }
__device__ __forceinline__ float one_minus_exp(float x) { return fabsf(x) < 2e-3f ? -x * (1.f + 0.5f * x * (1.f + x * (1.f / 3.f))) : 1.f - fexp(x); }
__device__ __forceinline__ void tr_item(const float* __restrict__ W, int ldw, int K, bf16_t* __restrict__ WT, int rstride, int roff, float* scr, int kb, int nb_, int lane) {
    const int k0 = 64 * kb, n0 = 32 * nb_;
#pragma unroll 8
    for (int i = 0; i < 32; ++i) { const int kk = 2 * i + (lane >> 5); scr[kk * 33 + (lane & 31)] = __builtin_nontemporal_load(W + (size_t)(k0 + kk) * ldw + n0 + (lane & 31)); }
    asm volatile("s_waitcnt lgkmcnt(0)" ::: "memory");
    const int c = lane & 7, rbase = (n0 >> 7) * rstride + (n0 & 127) + roff;
#pragma unroll
    for (int j = 0; j < 4; ++j) { const int n = (lane >> 3) + 8 * j; const float* s = scr + (8 * c) * 33 + n;
        u32x4 o; o.x = pk2bf(s[0 * 33], s[1 * 33]); o.y = pk2bf(s[2 * 33], s[3 * 33]); o.z = pk2bf(s[4 * 33], s[5 * 33]); o.w = pk2bf(s[6 * 33], s[7 * 33]);
        *(u32x4*)(WT + (size_t)(rbase + n) * K + k0 + 8 * c) = o; }
    asm volatile("s_waitcnt lgkmcnt(0)" ::: "memory");
}
__device__ __forceinline__ void tr_kind(const float* W, int ldw, size_t src_z, int K, int N, int nz, bf16_t* WT, int rstride, int roff, size_t dst_z, float* scr, int gw, int ngw, int lane) {
    const int nblk = N / 32, per = (K / 64) * nblk, total = per * nz;
    for (int it = gw; it < total; it += ngw) { const int z = it / per, r = it - z * per;
        tr_item(W + (size_t)z * src_z, ldw, K, WT + (size_t)z * dst_z, rstride, roff, scr, r / nblk, r % nblk, lane); }
}
__device__ __forceinline__ void ada_layer(const Params& P, char* lds, int l, int rank, int nranks) {
    const int tid = opaque_tid(), lane = tid & 63, wave = tid >> 6;
    float* cact = (float*)lds; float* red = cact + 2 * DM; float* mod = WSP(float, WS_MOD);
    for (int i = tid; i < 2 * DM; i += NTHR) { const float cv = P.c[i]; cact[i] = cv / (1.f + expf(-cv)); }
    __syncthreads();
    for (int it = rank; it < NADA / 64; it += nranks) {
        const int j = it * 64 + lane;
        const float* w = P.w_ada + ((size_t)l * DM + wave * 256) * NADA + j; const float* c0 = cact + wave * 256; const float* c1 = c0 + DM;
        float s0 = 0.f, s1 = 0.f;
#pragma unroll 32
        for (int kk = 0; kk < 256; ++kk) { const float wv = __builtin_nontemporal_load(w + (size_t)kk * NADA); s0 += c0[kk] * wv; s1 += c1[kk] * wv; }
        red[(wave * 64 + lane) * 2 + 0] = s0; red[(wave * 64 + lane) * 2 + 1] = s1;
        __syncthreads();
        if (tid < 128) { const int jj = tid & 63, b = tid >> 6, jc = it * 64 + jj; float s = P.b_ada[l * NADA + jc];
#pragma unroll
            for (int ks = 0; ks < 8; ++ks) s += red[(ks * 64 + jj) * 2 + b];
            mod[((size_t)l * 2 + b) * NADA + jc] = s; }
        __syncthreads();
    }
}
__device__ __forceinline__ void ph_prologue(const Params& P, char* lds, int bid, int nb) {
    const int tid = opaque_tid(), lane = tid & 63, wave = tid >> 6;
    if (bid == 0) for (int i = tid; i < DEPTH * LW; i += NTHR) WSP(float, WS_SPT)[i] = log1pf(expf(-P.lru_lam[i]));
    ada_layer(P, lds, 0, bid, nb);
    __syncthreads();
    float* scr = (float*)(lds + wave * 16384); const int gw = bid * 8 + wave, ngw = nb * 8;
    tr_kind(P.w_gate, DFF, (size_t)DM * DFF, DM, DFF, DEPTH, WSP(bf16_t, WS_WGU), 256, 0, (size_t)NGU * DM, scr, gw, ngw, lane);
    tr_kind(P.w_up, DFF, (size_t)DM * DFF, DM, DFF, DEPTH, WSP(bf16_t, WS_WGU), 256, 128, (size_t)NGU * DM, scr, gw, ngw, lane);
    tr_kind(P.w_down, DM, (size_t)DFF * DM, DFF, DM, DEPTH, WSP(bf16_t, WS_WDN), 128, 0, (size_t)DM * DFF, scr, gw, ngw, lane);
    tr_kind(P.w_in, NIN, (size_t)DM * NIN, DM, 3584, DEPTH, WSP(bf16_t, WS_WIN), 128, 0, (size_t)NZ * DM, scr, gw, ngw, lane);
    tr_kind(P.w_in + 3592, NIN, (size_t)DM * NIN, DM, 1024, DEPTH, WSP(bf16_t, WS_WIN), 128, 3584, (size_t)NZ * DM, scr, gw, ngw, lane);
    tr_kind(P.w_out, DM, (size_t)DM * DM, DM, DM, DEPTH, WSP(bf16_t, WS_WOUT), 128, 0, (size_t)DM * DM, scr, gw, ngw, lane);
    tr_kind(P.pool_w, 128, 16384, 128, 128, 4 * DEPTH, WSP(bf16_t, WS_WSM), 128, 0, 16384, scr, gw, ngw, lane);
    tr_kind(P.lru_wa, 128, 16384, 128, 128, 4 * DEPTH, WSP(bf16_t, WS_WSM) + 16 * 16384, 128, 0, 16384, scr, gw, ngw, lane);
    tr_kind(P.lru_wi, 128, 16384, 128, 128, 4 * DEPTH, WSP(bf16_t, WS_WSM) + 32 * 16384, 128, 0, 16384, scr, gw, ngw, lane);
}

using pg8::h16x8;
constexpr size_t WS_XH = 1100 * MiB;
template <int WHICH, bool XF32>
__device__ __forceinline__ void ph_norm(const Params& P, char* lds, int l, int bid, int nb) {
    const int tid = opaque_tid(), lane = tid & 63, wave = tid >> 6;
    const float* x = P.x_in; const _Float16* xh = WSP(const _Float16, WS_XH);
    const float* g = (WHICH ? P.g_ffn : P.g_mix) + l * DM; const float* modl = WSP(float, WS_MOD) + (size_t)l * 2 * NADA + (WHICH ? 3 * DM : 0);
    bf16_t* H = WSP(bf16_t, WS_H); float* FL = WSP(float, WS_FL);
    float* wft = (float*)lds;
    if (WHICH == 0) { const float* wf = P.w_in + (size_t)l * DM * NIN + 3584;
        for (int k = tid; k < DM; k += NTHR) { const f32x4 w0 = *(const f32x4*)(wf + (size_t)k * NIN), w1 = *(const f32x4*)(wf + (size_t)k * NIN + 4);
#pragma unroll
            for (int f = 0; f < 4; ++f) { wft[f * DM + k] = w0[f]; wft[(4 + f) * DM + k] = w1[f]; } }
        __syncthreads(); }
    for (int row = (bid * 8 + wave) * 2; row < M; row += nb * 16) {
        const float* xr = x + (size_t)row * DM; const _Float16* xhr = xh + (size_t)row * DM; const float* sh = modl + (row >> 13) * NADA; const float* sc = sh + DM;
        f32x4 v0[8], v1[8]; float ss0 = 0.f, ss1 = 0.f;
        if constexpr (XF32) {
#pragma unroll
            for (int j = 0; j < 8; ++j) { v0[j] = *(const f32x4*)(xr + j * 256 + lane * 4); v1[j] = *(const f32x4*)(xr + DM + j * 256 + lane * 4); }
            _Float16* xw = WSP(_Float16, WS_XH) + (size_t)row * DM;
#pragma unroll
            for (int j = 0; j < 8; ++j) { *(pg8::h16x4*)(xw + j * 256 + lane * 4) = __builtin_convertvector(v0[j], pg8::h16x4); *(pg8::h16x4*)(xw + DM + j * 256 + lane * 4) = __builtin_convertvector(v1[j], pg8::h16x4); }
        } else { pg8::h16x4 t0[8], t1[8];
#pragma unroll
            for (int j = 0; j < 8; ++j) { t0[j] = *(const pg8::h16x4*)(xhr + j * 256 + lane * 4); t1[j] = *(const pg8::h16x4*)(xhr + DM + j * 256 + lane * 4); }
#pragma unroll
            for (int j = 0; j < 8; ++j) { v0[j] = __builtin_convertvector(t0[j], f32x4); v1[j] = __builtin_convertvector(t1[j], f32x4); } }
#pragma unroll
        for (int j = 0; j < 8; ++j) { ss0 += v0[j][0] * v0[j][0] + v0[j][1] * v0[j][1] + v0[j][2] * v0[j][2] + v0[j][3] * v0[j][3];
                                      ss1 += v1[j][0] * v1[j][0] + v1[j][1] * v1[j][1] + v1[j][2] * v1[j][2] + v1[j][3] * v1[j][3]; }
        ss0 = wave_sum(ss0); ss1 = wave_sum(ss1);
        const float r0 = rsqrtf(ss0 * (1.f / DM) + 1e-6f), r1 = rsqrtf(ss1 * (1.f / DM) + 1e-6f);
        float fa0[8] = {0.f, 0.f, 0.f, 0.f, 0.f, 0.f, 0.f, 0.f}, fa1[8] = {0.f, 0.f, 0.f, 0.f, 0.f, 0.f, 0.f, 0.f};
#pragma unroll
        for (int j = 0; j < 8; ++j) {
            const int i0 = j * 256 + lane * 4; const f32x4 gg = *(const f32x4*)(g + i0), s1 = *(const f32x4*)(sc + i0), s0 = *(const f32x4*)(sh + i0);
            const f32x4 ga = gg * (s1 + 1.f); const f32x4 h0 = v0[j] * r0 * ga + s0, h1 = v1[j] * r1 * ga + s0;
            *(uint2*)(H + (size_t)row * DM + i0) = (uint2){pk2bf(h0[0], h0[1]), pk2bf(h0[2], h0[3])};
            *(uint2*)(H + (size_t)(row + 1) * DM + i0) = (uint2){pk2bf(h1[0], h1[1]), pk2bf(h1[2], h1[3])};
            if (WHICH == 0) {
#pragma unroll
                for (int f = 0; f < 8; ++f) { const f32x4 wv = *(const f32x4*)(wft + f * DM + i0);
                    fa0[f] += h0[0] * wv[0] + h0[1] * wv[1] + h0[2] * wv[2] + h0[3] * wv[3]; fa1[f] += h1[0] * wv[0] + h1[1] * wv[1] + h1[2] * wv[2] + h1[3] * wv[3]; }
            }
            if ((j & 3) == 3) asm volatile("" ::: "memory");
        }
        if (WHICH == 0) {
#pragma unroll
            for (int f = 0; f < 8; ++f) { fa0[f] = wave_sum(fa0[f]); fa1[f] = wave_sum(fa1[f]); }
            { float fv = fa0[0];
#pragma unroll
                for (int f = 1; f < 8; ++f) fv = (lane == f) ? fa0[f] : fv;
#pragma unroll
                for (int f = 0; f < 8; ++f) fv = (lane == 8 + f) ? fa1[f] : fv;
                const float lf = log_sigmoidf_(fv + P.b_f[l * 8 + (lane & 7)]);
                if (lane < 16) FL[((size_t)(row >> 13) * 8 + (lane & 7)) * SEQ + ((row + (lane >> 3)) & (SEQ - 1))] = lf; }
        }
    }
}

constexpr int MP_ZP = 0, MP_ZX = 20480, MP_AT = 0, MP_ABP = 38912, MP_ABX = 56320, MP_XC = 73728, MP_YT = 107520;
__device__ __forceinline__ void small_gemm(const char* atile, const bf16_t* __restrict__ Bt, int wave, int fr, int fq, f32x4 (&acc)[4]) {
    const char* ap = atile + ((wave & 3) * 16 + fr) * 272 + fq * 16; const bf16_t* bp = Bt + (size_t)((wave >> 2) * 64 + fr) * 128 + fq * 8;
#pragma unroll
    for (int j = 0; j < 4; ++j) acc[j] = (f32x4){0.f, 0.f, 0.f, 0.f};
#pragma unroll
    for (int k4 = 0; k4 < 4; ++k4) { const bf16x8 a = *(const bf16x8*)(ap + k4 * 64);
#pragma unroll
        for (int j = 0; j < 4; ++j) { const bf16x8 b = *(const bf16x8*)(bp + (size_t)j * 16 * 128 + k4 * 32); acc[j] = __builtin_amdgcn_mfma_f32_16x16x32_bf16(a, b, acc[j], 0, 0, 0); } }
}
__device__ __forceinline__ void sg_loadb(const bf16_t* __restrict__ Bt, int wave, int fr, int fq, bf16x8 (&b)[16]) {
    const bf16_t* bp = Bt + (size_t)((wave >> 2) * 64 + fr) * 128 + fq * 8;
#pragma unroll
    for (int k4 = 0; k4 < 4; ++k4)
#pragma unroll
        for (int j = 0; j < 4; ++j) b[k4 * 4 + j] = *(const bf16x8*)(bp + (size_t)j * 16 * 128 + k4 * 32);
}
__device__ __forceinline__ void sg_mma(const char* atile, const bf16x8 (&b)[16], int wave, int fr, int fq, f32x4 (&acc)[4]) {
    const char* ap = atile + ((wave & 3) * 16 + fr) * 272 + fq * 16;
#pragma unroll
    for (int j = 0; j < 4; ++j) acc[j] = (f32x4){0.f, 0.f, 0.f, 0.f};
#pragma unroll
    for (int k4 = 0; k4 < 4; ++k4) { const bf16x8 a = *(const bf16x8*)(ap + k4 * 64);
#pragma unroll
        for (int j = 0; j < 4; ++j) acc[j] = __builtin_amdgcn_mfma_f32_16x16x32_bf16(a, b[k4 * 4 + j], acc[j], 0, 0, 0); }
}
__device__ __forceinline__ void mp_load(const Params& P, int rt, int j, int tid, u32x4 (&pre)[5]) {
    const int r0 = rt * 64, t0 = r0 & (SEQ - 1); const bf16_t* ZP = WSP(const bf16_t, WS_ZP); const bf16_t* ZX = WSP(const bf16_t, WS_ZX);
#pragma unroll
    for (int k = 0; k < 5; ++k) { const int ch = tid + NTHR * k; const bool isx = ch >= 79 * 16; const int cc = isx ? ch - 79 * 16 : ch, row = cc >> 4, c16 = cc & 15, back = isx ? 3 : 15;
        pre[k] = (u32x4){0u, 0u, 0u, 0u};
        if (ch < (79 + 67) * 16 && t0 - back + row >= 0) pre[k] = *(const u32x4*)((isx ? ZX : ZP) + (size_t)(r0 - back + row) * 512 + j * 128 + c16 * 8); }
}
__device__ __forceinline__ void mp_store(char* lds, int tid, const u32x4 (&pre)[5]) {
#pragma unroll
    for (int k = 0; k < 5; ++k) { const int ch = tid + NTHR * k; const bool isx = ch >= 79 * 16; const int cc = isx ? ch - 79 * 16 : ch, row = cc >> 4, c16 = cc & 15;
        if (ch < (79 + 67) * 16) *(u32x4*)(lds + (isx ? MP_ZX : MP_ZP) + row * 256 + c16 * 16) = pre[k]; }
}
__device__ __forceinline__ void mp_unit(const Params& P, char* lds, int l, int rt, int j, u32x4 (&pre)[5], int rt_next, int j_next) {
    const int tid = opaque_tid(), lane = tid & 63, wave = tid >> 6, fr = lane & 15, fq = lane >> 4;
    const int r0 = rt * 64, t0 = r0 & (SEQ - 1), win = 2 << j;
    bf16x8 bpool[16]; sg_loadb(WSP(const bf16_t, WS_WSM) + (size_t)(l * 4 + j) * 16384, wave, fr, fq, bpool);
    mp_store(lds, tid, pre);
    __syncthreads();
    { const int c8 = tid & 15, rg = tid >> 4, chn = j * 128 + c8 * 8;
        float cw[4][8], cb[8]; const float* cwp = P.lru_cw + (size_t)l * 4 * LW + chn; const float* cbp = P.lru_cb + l * LW + chn;
#pragma unroll
        for (int k = 0; k < 4; ++k) { const f32x4 a = *(const f32x4*)(cwp + k * LW), b = *(const f32x4*)(cwp + k * LW + 4);
#pragma unroll
            for (int e = 0; e < 4; ++e) { cw[k][e] = a[e]; cw[k][4 + e] = b[e]; } }
        { const f32x4 a = *(const f32x4*)cbp, b = *(const f32x4*)(cbp + 4);
#pragma unroll
            for (int e = 0; e < 4; ++e) { cb[e] = a[e]; cb[4 + e] = b[e]; } }
#pragma unroll
        for (int rr = 0; rr < 2; ++rr) { const int row = rg * 2 + rr, t = t0 + row; float s[8], u[8], xc[8];
            { const u32x4 z = *(const u32x4*)(lds + MP_ZP + (row + 15) * 256 + c8 * 16); UNPACK8(z, u); }
#pragma unroll
            for (int e = 0; e < 8; ++e) { s[e] = u[e]; xc[e] = cb[e]; }
            for (int q = 1; q < win; ++q) { const u32x4 z = *(const u32x4*)(lds + MP_ZP + (row + 15 - q) * 256 + c8 * 16); float zf[8]; UNPACK8(z, zf);
#pragma unroll
                for (int e = 0; e < 8; ++e) s[e] += zf[e]; }
            const float rn = __builtin_amdgcn_rcpf((float)((t + 1 < win) ? t + 1 : win)); float d[8];
#pragma unroll
            for (int e = 0; e < 8; ++e) d[e] = s[e] * rn - u[e];
            *(u32x4*)(lds + MP_ABP + row * 272 + c8 * 16) = PACK8(d);
#pragma unroll
            for (int k = 0; k < 4; ++k) { const u32x4 z = *(const u32x4*)(lds + MP_ZX + (row + k) * 256 + c8 * 16); float zf[8]; UNPACK8(z, zf);
#pragma unroll
                for (int e = 0; e < 8; ++e) xc[e] += cw[k][e] * zf[e]; }
            float* xo = (float*)(lds + MP_XC) + row * 132 + c8 * 8;
            *(f32x4*)xo = (f32x4){xc[0], xc[1], xc[2], xc[3]}; *(f32x4*)(xo + 4) = (f32x4){xc[4], xc[5], xc[6], xc[7]};
            *(u32x4*)(lds + MP_ABX + row * 272 + c8 * 16) = PACK8(xc); } }
    __syncthreads();
    if (rt_next >= 0) mp_load(P, rt_next, j_next, tid, pre);
    { const bf16_t* wsm = WSP(const bf16_t, WS_WSM);
        { f32x4 acc[4]; sg_mma(lds + MP_ABP, bpool, wave, fr, fq, acc);
#pragma unroll
            for (int q = 0; q < 4; ++q) { const int lc = (wave >> 2) * 64 + 16 * q + fr; const float sc = P.pool_scale[l * PW + j * 128 + lc];
#pragma unroll
                for (int e = 0; e < 4; ++e) { const int lr = (wave & 3) * 16 + fq * 4 + e; ((bf16_t*)(lds + MP_YT))[lr * 128 + lc] = (bf16_t)pk2bf(acc[q][e] * sc, 0.f); } } }
        f32x4 ga[4], gi[4];
        small_gemm(lds + MP_ABX, wsm + (size_t)(16 + l * 4 + j) * 16384, wave, fr, fq, ga);
        small_gemm(lds + MP_ABX, wsm + (size_t)(32 + l * 4 + j) * 16384, wave, fr, fq, gi);
#pragma unroll
        for (int q = 0; q < 4; ++q) { const int lc = (wave >> 2) * 64 + 16 * q + fr, chn = j * 128 + lc;
            const float ba = P.lru_ba[l * LW + chn], bi = P.lru_bi[l * LW + chn], sp = WSP(const float, WS_SPT)[l * LW + chn];
#pragma unroll
            for (int e = 0; e < 4; ++e) { const int lr = (wave & 3) * 16 + fq * 4 + e; float* xp = (float*)(lds + MP_XC) + lr * 132 + lc;
                const float gr = fsigmoid(ga[q][e] + ba), gin = fsigmoid(gi[q][e] + bi), la = -8.f * gr * sp;
                const float inp = __builtin_amdgcn_sqrtf(one_minus_exp(2.f * la)) * (gin * *xp);
                *xp = inp; ((float*)(lds + MP_AT))[lr * 132 + lc] = fexp(la); } } }
    __syncthreads();
    if (tid < 128) { float h = 0.f, p = 1.f; float* xc = (float*)(lds + MP_XC) + tid; float* at = (float*)(lds + MP_AT) + tid;
#pragma unroll 8
        for (int r = 0; r < 64; ++r) { const float a = at[r * 132]; h = a * h + xc[r * 132]; p *= a; xc[r * 132] = h; at[r * 132] = p; }
        const size_t so = ((size_t)(r0 >> 13) * 128 + (t0 >> 6)) * LW + j * 128 + tid;
        WSP(float, WS_CSA)[so] = p; WSP(float, WS_CSH)[so] = h; }
    else { bf16_t* Y = WSP(bf16_t, WS_Y);
        for (int idx = tid - 128; idx < 1024; idx += NTHR - 128) { const int row = idx >> 4, c16 = idx & 15;
            *(u32x4*)(Y + (size_t)(r0 + row) * DM + j * 128 + c16 * 8) = *(const u32x4*)(lds + MP_YT + row * 256 + c16 * 16); } }
    __syncthreads();
    { _Float16* HL = WSP(_Float16, WS_LRUA); _Float16* PC = WSP(_Float16, WS_LRUB);
#pragma unroll
        for (int idx = tid; idx < 1024; idx += NTHR) { const int row = idx >> 4, c8 = idx & 15; const size_t go = (size_t)(r0 + row) * LW + j * 128 + c8 * 8;
            const float* xs = (const float*)(lds + MP_XC) + row * 132 + c8 * 8; const float* as = (const float*)(lds + MP_AT) + row * 132 + c8 * 8;
            const pg8::h16x4 h0 = __builtin_convertvector(*(const f32x4*)xs, pg8::h16x4), h1 = __builtin_convertvector(*(const f32x4*)(xs + 4), pg8::h16x4);
            const pg8::h16x4 p0 = __builtin_convertvector(*(const f32x4*)as, pg8::h16x4), p1 = __builtin_convertvector(*(const f32x4*)(as + 4), pg8::h16x4);
            *(h16x8*)(HL + go) = __builtin_shufflevector(h0, h1, 0, 1, 2, 3, 4, 5, 6, 7); *(h16x8*)(PC + go) = __builtin_shufflevector(p0, p1, 0, 1, 2, 3, 4, 5, 6, 7); } }
    __syncthreads();
}
__device__ __forceinline__ void fscan_wave(const Params& P, char* lds, int bh) {
    const int tid_ = opaque_tid(), lane = tid_ & 63, wave = tid_ >> 6;
    const f32x4* src = (const f32x4*)(WSP(const float, WS_FL) + (size_t)bh * SEQ + lane * 128); f32x4* dst = (f32x4*)(WSP(float, WS_F) + (size_t)bh * SEQ + lane * 128);
    f32x4 v[32]; float tot = 0.f;
#pragma unroll
    for (int i = 0; i < 32; ++i) v[i] = src[i];
#pragma unroll
    for (int i = 0; i < 32; ++i) { v[i][0] += tot; v[i][1] += v[i][0]; v[i][2] += v[i][1]; v[i][3] += v[i][2]; tot = v[i][3]; }
    float* sc = (float*)lds + wave * 64; sc[lane] = tot;
    asm volatile("s_waitcnt lgkmcnt(0)" ::: "memory");
    float off = 0.f;
    for (int i = 0; i < 64; ++i) { const float t = sc[i]; off += (i < lane) ? t : 0.f; }
#pragma unroll
    for (int i = 0; i < 32; ++i) dst[i] = v[i] + off;
}
__device__ __forceinline__ void ph_mixprep(const Params& P, char* lds, int l, int bid, int nb) {
    if (bid >= 1024) return;
    const int rot = (nb & 3) == 0 ? 1 : 0; int k = 0;
    u32x4 pre[5]; mp_load(P, bid >> 2, bid & 3, opaque_tid(), pre);
    for (int u = bid; u < 1024; u += nb, k += rot) { const int un = u + nb;
        mp_unit(P, lds, l, u >> 2, ((u & 3) + k) & 3, pre, un < 1024 ? (un >> 2) : -1, ((un & 3) + k + rot) & 3); }
}
__device__ __forceinline__ void lru_fixup_tile(const Params& P, char* lds, int rt) {
    const int tid = opaque_tid(), r0 = rt * 64, b = r0 >> 13, chunk = (r0 & (SEQ - 1)) >> 6, hlf = chunk >> 1;
    float* carry = (float*)lds;
    { const float* ca = WSP(const float, WS_CSA) + (size_t)b * 128 * LW + tid; const float* chh = WSP(const float, WS_CSH) + (size_t)b * 128 * LW + tid;
        float s1 = 0.f, a2 = 1.f, s2 = 0.f;
#pragma unroll 8
        for (int i = 0; i < hlf; ++i) { const float x1 = ca[(size_t)i * LW], y1 = chh[(size_t)i * LW], x2 = ca[(size_t)(hlf + i) * LW], y2 = chh[(size_t)(hlf + i) * LW];
            s1 = x1 * s1 + y1; s2 = x2 * s2 + y2; a2 *= x2; }
        float cin = a2 * s1 + s2;
        if (chunk & 1) cin = ca[(size_t)(chunk - 1) * LW] * cin + chh[(size_t)(chunk - 1) * LW];
        carry[tid] = cin; }
    __syncthreads();
    const _Float16* HL = WSP(const _Float16, WS_LRUA); const _Float16* PC = WSP(const _Float16, WS_LRUB); const bf16_t* ZY = WSP(const bf16_t, WS_ZY); bf16_t* Y = WSP(bf16_t, WS_Y);
#pragma unroll 4
    for (int idx = tid; idx < 4096; idx += NTHR) { const int row = idx >> 6, c8 = idx & 63; const size_t off = (size_t)(r0 + row) * LW + c8 * 8;
        const h16x8 hh = *(const h16x8*)(HL + off), pp = *(const h16x8*)(PC + off);
        const f32x4 h0 = __builtin_convertvector(__builtin_shufflevector(hh, hh, 0, 1, 2, 3), f32x4), h1 = __builtin_convertvector(__builtin_shufflevector(hh, hh, 4, 5, 6, 7), f32x4);
        const f32x4 p0 = __builtin_convertvector(__builtin_shufflevector(pp, pp, 0, 1, 2, 3), f32x4), p1 = __builtin_convertvector(__builtin_shufflevector(pp, pp, 4, 5, 6, 7), f32x4);
        const f32x4 c0 = *(const f32x4*)(carry + c8 * 8), c1 = *(const f32x4*)(carry + c8 * 8 + 4); const u32x4 zy = *(const u32x4*)(ZY + off); float zf[8], y[8]; UNPACK8(zy, zf);
#pragma unroll
        for (int e = 0; e < 4; ++e) { y[e] = (h0[e] + p0[e] * c0[e]) * fgelu_tanh(zf[e]); y[4 + e] = (h1[e] + p1[e] * c1[e]) * fgelu_tanh(zf[4 + e]); }
        *(u32x4*)(Y + (size_t)(r0 + row) * DM + 1536 + c8 * 8) = PACK8(y); }
    __syncthreads();
}
constexpr size_t WS_SIDE = WS_SCR;
__device__ __forceinline__ void ffn_fix_tile(const Params& P, int l, int pm) {
    const float* side = WSP(const float, WS_SIDE) + (size_t)pm * 6 * DFF; bf16_t* ACT = WSP(bf16_t, WS_ACT) + (size_t)pm * 256 * DFF;
    const float* cwp = P.ffn_cw + (size_t)l * 3 * DFF; const float* cbp = P.ffn_cb + l * DFF; const bool first = (pm & 31) == 0;
    for (int i = opaque_tid(); i < DFF / 8; i += NTHR) { const int c = i * 8;
#pragma unroll
        for (int h = 0; h < 2; ++h) { const int cc = c + 4 * h;
            const f32x4 g0 = *(const f32x4*)(side + cc), g1 = *(const f32x4*)(side + DFF + cc), u0 = *(const f32x4*)(side + 2 * DFF + cc), u1 = *(const f32x4*)(side + 3 * DFF + cc);
            f32x4 gm2 = {0.f, 0.f, 0.f, 0.f}, gm1 = {0.f, 0.f, 0.f, 0.f};
            if (!first) { gm2 = *(const f32x4*)(side - 2 * DFF + cc); gm1 = *(const f32x4*)(side - DFF + cc); }
            const f32x4 w0 = *(const f32x4*)(cwp + cc), w1 = *(const f32x4*)(cwp + DFF + cc), w2 = *(const f32x4*)(cwp + 2 * DFF + cc), bb = *(const f32x4*)(cbp + cc);
            float a0[4], a1[4];
#pragma unroll
            for (int e = 0; e < 4; ++e) { const float ga = bb[e] + w0[e] * gm2[e] + w1[e] * gm1[e] + w2[e] * g0[e], gb = bb[e] + w0[e] * gm1[e] + w1[e] * g0[e] + w2[e] * g1[e];
                a0[e] = ga * fsigmoid(ga) * u0[e]; a1[e] = gb * fsigmoid(gb) * u1[e]; }
            *(uint2*)(ACT + cc) = (uint2){pk2bf(a0[0], a0[1]), pk2bf(a0[2], a0[3])}; *(uint2*)(ACT + DFF + cc) = (uint2){pk2bf(a1[0], a1[1]), pk2bf(a1[2], a1[3])}; }
    }
}
__device__ __forceinline__ void ph_finalnorm(const Params& P, int bid, int nb) {
    const int tid_ = opaque_tid(), lane = tid_ & 63, wave = tid_ >> 6;
    f32x4 gg[8];
#pragma unroll
    for (int j = 0; j < 8; ++j) gg[j] = *(const f32x4*)(P.final_g + j * 256 + lane * 4);
    for (int row = (bid * 8 + wave) * 2; row < M; row += nb * 16) { float* xr = P.out + (size_t)row * DM; const _Float16* xhr = WSP(const _Float16, WS_XH) + (size_t)row * DM;
        f32x4 v0[8], v1[8]; float ss0 = 0.f, ss1 = 0.f;
        { pg8::h16x4 t0[8], t1[8];
#pragma unroll
            for (int j = 0; j < 8; ++j) { t0[j] = *(const pg8::h16x4*)(xhr + j * 256 + lane * 4); t1[j] = *(const pg8::h16x4*)(xhr + DM + j * 256 + lane * 4); }
#pragma unroll
            for (int j = 0; j < 8; ++j) { v0[j] = __builtin_convertvector(t0[j], f32x4); v1[j] = __builtin_convertvector(t1[j], f32x4); } }
#pragma unroll
        for (int j = 0; j < 8; ++j) { ss0 += v0[j][0] * v0[j][0] + v0[j][1] * v0[j][1] + v0[j][2] * v0[j][2] + v0[j][3] * v0[j][3];
                                      ss1 += v1[j][0] * v1[j][0] + v1[j][1] * v1[j][1] + v1[j][2] * v1[j][2] + v1[j][3] * v1[j][3]; }
        ss0 = wave_sum(ss0); ss1 = wave_sum(ss1);
        const float r0 = rsqrtf(ss0 * (1.f / DM) + 1e-6f), r1 = rsqrtf(ss1 * (1.f / DM) + 1e-6f);
#pragma unroll
        for (int j = 0; j < 8; ++j) { const int i0 = j * 256 + lane * 4; *(f32x4*)(xr + i0) = v0[j] * r0 * gg[j]; *(f32x4*)(xr + DM + i0) = v1[j] * r1 * gg[j]; } }
}
constexpr int CW_SPLIT = 10240;
__device__ __forceinline__ void split_arrive(unsigned* cnt) {
    asm volatile("s_waitcnt vmcnt(0)" ::: "memory"); __syncthreads();
    if (threadIdx.x == 0) { __builtin_amdgcn_fence(__ATOMIC_RELEASE, "agent"); asm volatile("s_waitcnt vmcnt(0)" ::: "memory");
        (void)__hip_atomic_fetch_add(cnt, 1u, __ATOMIC_RELAXED, __HIP_MEMORY_SCOPE_AGENT); }
}
__device__ __forceinline__ void split_wait(unsigned* cnt, unsigned want, unsigned* tmo) {
    if (threadIdx.x == 0) { unsigned sp = 0;
        while (__hip_atomic_load(cnt, __ATOMIC_RELAXED, __HIP_MEMORY_SCOPE_AGENT) < want) { __builtin_amdgcn_s_sleep(1);
            if ((++sp & 255u) == 0u) { if (__hip_atomic_load(tmo, __ATOMIC_RELAXED, __HIP_MEMORY_SCOPE_AGENT)) break; if (sp > (1u << 18)) { atomicAdd(tmo, 1u); break; } } }
        __builtin_amdgcn_fence(__ATOMIC_ACQUIRE, "agent"); asm volatile("s_waitcnt vmcnt(0)" ::: "memory"); }
    __syncthreads();
}
typedef fox::BlockRef<fox::bf16, fox::bf16> FoxRef;
constexpr size_t WS_SMIN = WS_SPT + 64 * 1024;
__device__ __forceinline__ void ph_selfmin(const Params& P, char* lds, int bid, int nb) {
    const int tid = opaque_tid(), lane = tid & 63, wave = tid >> 6, c = lane & 15, r4 = lane >> 4;
    const bf16_t* Q = WSP(const bf16_t, WS_Q); const bf16_t* K = WSP(const bf16_t, WS_K); float* red = (float*)lds;
    for (int p = bid; p < 512; p += nb) {
        const size_t base = ((size_t)p * 256 + wave * 32 + r4) * 128 + c * 8;
        u32x4 qv[8], kv[8];
#pragma unroll
        for (int it = 0; it < 8; ++it) { qv[it] = *(const u32x4*)(Q + base + (size_t)it * 4 * 128); kv[it] = *(const u32x4*)(K + base + (size_t)it * 4 * 128); }
        float mn = 1e30f;
#pragma unroll
        for (int it = 0; it < 8; ++it) { float qf[8], kf[8]; UNPACK8(qv[it], qf); UNPACK8(kv[it], kf);
            float d = (qf[0] * kf[0] + qf[1] * kf[1]) + (qf[2] * kf[2] + qf[3] * kf[3]) + (qf[4] * kf[4] + qf[5] * kf[5]) + (qf[6] * kf[6] + qf[7] * kf[7]);
            d += __builtin_bit_cast(float, __builtin_amdgcn_ds_swizzle(__builtin_bit_cast(int, d), 0x041f)); d += __builtin_bit_cast(float, __builtin_amdgcn_ds_swizzle(__builtin_bit_cast(int, d), 0x081f));
            d += __builtin_bit_cast(float, __builtin_amdgcn_ds_swizzle(__builtin_bit_cast(int, d), 0x101f)); d += __builtin_bit_cast(float, __builtin_amdgcn_ds_swizzle(__builtin_bit_cast(int, d), 0x201f));
            mn = fminf(mn, d); }
        mn = fminf(mn, __builtin_bit_cast(float, __builtin_amdgcn_ds_swizzle(__builtin_bit_cast(int, mn), 0x401f)));
        { const auto rr = __builtin_amdgcn_permlane32_swap(__builtin_bit_cast(unsigned, mn), __builtin_bit_cast(unsigned, mn), false, false); mn = fminf(__builtin_bit_cast(float, rr[0]), __builtin_bit_cast(float, rr[1])); }
        if (lane == 0) red[wave] = mn;
        __syncthreads();
        if (tid == 0) { float m8 = red[0];
#pragma unroll
            for (int w = 1; w < 8; ++w) m8 = fminf(m8, red[w]);
            WSP(float, WS_SMIN)[p] = fminf(m8 * fox::SCALE, 0.f); }
        __syncthreads();
    }
}
constexpr int CW_NRM = 12288;
constexpr size_t WS_ATST = WS_SCR + 16 * MiB;
constexpr int LDS_ATAB = 69632;
constexpr int LDS_CMB = LDS_MISC + 128;
constexpr int FOX_OVH = 4;
struct FoxCut { int start, end, v; };
__device__ __forceinline__ FoxRef fox_piece(int i, const FoxCut& c, const int* nt, const int* pe, const bf16_t* Q, const bf16_t* K, const bf16_t* V, const float* F, bf16_t* Y, float* ST) {
    const int bh = i >> 5, qb = 31 - (i & 31), b = bh >> 3, hh = bh & 7, ntb = nt[i], p0 = pe[i];
    const int ta = c.start > p0 + FOX_OVH ? c.start - p0 - FOX_OVH : 0, tb = (c.end - p0 - FOX_OVH < ntb) ? c.end - p0 - FOX_OVH : ntb;
    FoxRef r; const size_t ho = (size_t)bh * SEQ * 128;
    r.Q = Q + ho + (size_t)qb * 256 * 128; r.K = K + ho; r.V = V + ho; r.O = Y + ((size_t)b * SEQ + qb * 256) * DM + 512 + hh * 128;
    r.F = F + (size_t)bh * SEQ; r.fref = r.F[qb * 256]; r.P0 = qb * 256;
    r.jhi = 4 * qb + 4 - ta; r.jlo = 4 * qb + 4 - tb;
    r.st = (tb - ta < ntb) ? ST + (size_t)(c.v * 2 + (ta > 0 ? 0 : 1)) * (512 * 68) : nullptr;
    return r;
}
__device__ __forceinline__ void ph_attn(const Params& P, char* lds, int l, int bid, int nb) {
    const bf16_t* Q = WSP(const bf16_t, WS_Q); const bf16_t* K = WSP(const bf16_t, WS_K); const bf16_t* V = WSP(const bf16_t, WS_V); const float* F = WSP(const float, WS_F); bf16_t* Y = WSP(bf16_t, WS_Y);
    const unsigned* nrm = WSP(const unsigned, WS_CTL) + CW_NRM + l * 128; float* ST = WSP(float, WS_ATST);
    const int tid = opaque_tid();
    int* nt = (int*)(lds + LDS_ATAB); int* pe = nt + 512; volatile int* cmb = (volatile int*)(lds + LDS_CMB); volatile int* first = (volatile int*)(lds + LDS_ATAB + 8192);
    { const int i = tid, bh = i >> 5, qb = 31 - (i & 31); const float* Fh = F + (size_t)bh * SEQ; const unsigned* n8 = nrm + bh * 8;
        const float q2 = (__uint_as_float(n8[0]) + __uint_as_float(n8[1])) + (__uint_as_float(n8[2]) + __uint_as_float(n8[3])), k2 = (__uint_as_float(n8[4]) + __uint_as_float(n8[5])) + (__uint_as_float(n8[6]) + __uint_as_float(n8[7]));
        const float thr = Fh[qb * 256] + 89.f + 1.02f * fox::SCALE * sqrtf(q2 * k2) - WSP(const float, WS_SMIN)[bh * 32 + qb];
        int lo = 0, hi_ = qb * 4;
        while (lo < hi_) { const int mid = (lo + hi_) >> 1; if (Fh[mid * 64 + 63] > thr) lo = mid + 1; else hi_ = mid; }
        const int n = 4 * qb + 4 - lo; nt[i] = n;
        int val = n + FOX_OVH;
        for (int d = 1; d < 512; d <<= 1) { pe[i] = val; __syncthreads(); if (i >= d) val += pe[i - d]; __syncthreads(); }
        pe[i] = val - n - FOX_OVH; if (i == 511) pe[512] = val; if (i == 0) { cmb[0] = -1; cmb[1] = 0; }
    }
    __syncthreads();
    FoxCut c; { const int T = pe[512]; c.v = (nb % 8 == 0) ? (bid & 7) * (nb >> 3) + (bid >> 3) : bid;
        c.start = (int)((unsigned)(c.v * T) / (unsigned)nb); c.end = (int)((unsigned)((c.v + 1) * T) / (unsigned)nb);
        if (c.end <= c.start) return;
        if (pe[tid] <= c.start && c.start < pe[tid] + nt[tid] + FOX_OVH) first[0] = tid;
        __syncthreads();
        const int i0 = __builtin_amdgcn_readfirstlane(first[0]);
        { const int il = tid, f0 = pe[il] + FOX_OVH; if (f0 >= c.start && f0 < c.end && f0 + nt[il] > c.end) { cmb[0] = il; cmb[1] = (int)((unsigned)((f0 + nt[il]) * nb - 1) / (unsigned)T); } }
        int i = i0; FoxRef cur = fox_piece(i, c, nt, pe, Q, K, V, F, Y, ST);
        fox::Seam<fox::bf16> S;
        fox::causal_swa_prime<fox::bf16, fox::bf16>(cur, SEQ, lds, S);
        for (;;) {
            const int in = i + 1; const bool more = in < 512 && __builtin_amdgcn_readfirstlane(pe[in < 512 ? in : 511]) + FOX_OVH < c.end;
            const FoxRef nxt = more ? fox_piece(in, c, nt, pe, Q, K, V, F, Y, ST) : cur;
            fox::causal_swa_block<fox::bf16, fox::bf16>(cur, nxt, SEQ, SEQ, lds, S);
            if (!more) break;
            cur = nxt; i = in;
        }
    }
}
__device__ __forceinline__ void ph_attn_combine(const Params& P, char* lds, int bid, int nb) {
    volatile int* cmb = (volatile int*)(lds + LDS_CMB);
    const int blk = __builtin_amdgcn_readfirstlane(cmb[0]), wlast = __builtin_amdgcn_readfirstlane(cmb[1]);
    if (blk < 0) return;
    const int tid = opaque_tid(), lane = tid & 63, wid = tid >> 6, r32 = lane & 31, hi = lane >> 5;
    const int v = (nb % 8 == 0) ? (bid & 7) * (nb >> 3) + (bid >> 3) : bid, bh = blk >> 5, qb = 31 - (blk & 31);
    const float* ST = WSP(const float, WS_ATST); float* ws = (float*)lds + wid * 64;
    constexpr float C2 = 1.4426950408889634f * fox::SCALE;
    float Mx = -1e30f, L = 0.f; fox::f32x16 o[4] = {};
    for (int w = v; w <= wlast; ++w) {
        const float* sp = ST + ((size_t)(w * 2 + (w == v ? 1 : 0)) * 512 + wid * 64) * 68 + lane * 4;
        const f32x4 ml = *(const f32x4*)(sp + 16 * 256); const float Mn = fmaxf(Mx, ml[0]);
        const float ao = __builtin_amdgcn_exp2f((Mx - Mn) * C2), an = __builtin_amdgcn_exp2f((ml[0] - Mn) * C2);
        L = L * ao + ml[1] * an; Mx = Mn;
        if (hi == 0) { ws[r32] = ao; ws[32 + r32] = an; }
        asm volatile("s_waitcnt lgkmcnt(0)" ::: "memory");
#pragma unroll
        for (int d0 = 0; d0 < 4; ++d0)
#pragma unroll
            for (int q4 = 0; q4 < 4; ++q4) { const f32x4 pv = *(const f32x4*)(sp + (d0 * 4 + q4) * 256);
#pragma unroll
                for (int e = 0; e < 4; ++e) { const int r = q4 * 4 + e, row = fox::crow(r, hi); o[d0][r] = o[d0][r] * ws[row] + pv[e] * ws[32 + row]; } }
        asm volatile("s_waitcnt lgkmcnt(0)" ::: "memory");
    }
    if (hi == 0) ws[r32] = L;
    asm volatile("s_waitcnt lgkmcnt(0)" ::: "memory");
    bf16_t* Ow = WSP(bf16_t, WS_Y) + ((size_t)(bh >> 3) * SEQ + qb * 256 + wid * 32) * DM + 512 + (bh & 7) * 128;
#pragma unroll
    for (int r = 0; r < 16; ++r) { const int orow = fox::crow(r, hi); const float rl = __builtin_amdgcn_rcpf(ws[orow]);
#pragma unroll
        for (int d0 = 0; d0 < 4; ++d0) { const float vv = o[d0][r] * rl;
            const float vn = __builtin_bit_cast(float, __builtin_amdgcn_mov_dpp(__builtin_bit_cast(int, vv), 0xB1, 0xF, 0xF, true));
            if ((r32 & 1) == 0) *(unsigned*)(Ow + (size_t)orow * DM + d0 * 32 + r32) = fox::cvtpk(vv, vn); } }
}

#define XB_TMO      128
#define XB_XCNT(j)  (256  + 64 * (j))
#define XB_XSUB(j)  (1280 + 64 * (j))
#define XB_XGEN(j)  (2304 + 64 * (j))
#define XB_TOP      3328
#define XB_TOPGEN   3392
#define XCD_BAR_WORDS 3456
#define XB_SPIN_CAP (1u << 18)

__device__ __forceinline__ unsigned xb_ld(unsigned* p)              { return __hip_atomic_load(p, __ATOMIC_RELAXED, __HIP_MEMORY_SCOPE_AGENT); }
__device__ __forceinline__ unsigned xb_add(unsigned* p, unsigned v) { return __hip_atomic_fetch_add(p, v, __ATOMIC_RELAXED, __HIP_MEMORY_SCOPE_AGENT); }
__device__ __forceinline__ unsigned xb_xcc_id() { return (unsigned)__builtin_amdgcn_s_getreg((3 << 11) | 20) & 0xFu; }
#define XB_SPIN(cond, bar) do { unsigned _sp = 0; while (cond) { __builtin_amdgcn_s_sleep(1); \
    if ((++_sp & 255u) == 0u) { if (xb_ld(&(bar)[XB_TMO])) break; if (_sp > XB_SPIN_CAP) { atomicAdd(&(bar)[XB_TMO], 1u); break; } } } } while (0)

struct XcdBarrier {
    unsigned* bar; unsigned x;
    volatile LAS unsigned* st;
};

__device__ __forceinline__ XcdBarrier xcd_barrier_post(unsigned* bar, volatile LAS unsigned* st) {
    XcdBarrier b; b.bar = bar; b.x = xb_xcc_id(); b.st = st;
    if (threadIdx.x == 0) (void)xb_add(&bar[XB_XCNT(b.x)], 1u);
    return b;
}
__device__ __forceinline__ void xcd_barrier_complete(unsigned* bar, unsigned x, unsigned& nloc, unsigned& nx) {
    const unsigned G = gridDim.x * gridDim.y * gridDim.z;
    unsigned sum, cnt, mine, sp = 0u;
    for (;;) {
        sum = 0u; cnt = 0u; mine = 0u;
#pragma unroll
        for (unsigned j = 0; j < 16; ++j) { const unsigned c = xb_ld(&bar[XB_XCNT(j)]); sum += c; cnt += (c > 0u) ? 1u : 0u; mine = (j == x) ? c : mine; }
        if (sum == G) break;
        __builtin_amdgcn_s_sleep(1);
        if ((++sp & 255u) == 0u) { if (xb_ld(&bar[XB_TMO])) break; if (sp > XB_SPIN_CAP) { atomicAdd(&bar[XB_TMO], 1u); break; } }
    }
    nloc = mine > 0u ? mine : 1u; nx = cnt > 0u ? cnt : 1u;
}

__device__ __forceinline__ void xcd_barrier(const XcdBarrier& b) {
    asm volatile("s_waitcnt vmcnt(0)" ::: "memory");
    __syncthreads();
    if (threadIdx.x == 0) {
        unsigned* bar = b.bar;
        __builtin_amdgcn_s_waitcnt(0);
        unsigned nloc = b.st[0], nx = b.st[1];
        if (nloc == 0u) { xcd_barrier_complete(bar, b.x, nloc, nx); b.st[0] = nloc; b.st[1] = nx; }
        const unsigned old = xb_add(&bar[XB_XSUB(b.x)], 1u);
        const unsigned gen = old / nloc;
        if (old + 1u == (gen + 1u) * nloc) {
            __builtin_amdgcn_fence(__ATOMIC_RELEASE, "agent");
            asm volatile("s_waitcnt vmcnt(0)" ::: "memory");
            const unsigned og = xb_add(&bar[XB_TOP], 1u);
            const unsigned tg = og / nx;
            if (og + 1u == (tg + 1u) * nx) xb_add(&bar[XB_TOPGEN], 1u);
            else XB_SPIN(xb_ld(&bar[XB_TOPGEN]) == tg, bar);
            __builtin_amdgcn_fence(__ATOMIC_ACQUIRE, "agent");
            xb_add(&bar[XB_XGEN(b.x)], 1u);
            asm volatile("s_waitcnt vmcnt(0)" ::: "memory");
        } else {
            XB_SPIN(xb_ld(&bar[XB_XGEN(b.x)]) == gen, bar);
            __builtin_amdgcn_fence(__ATOMIC_ACQUIRE, "agent");
            asm volatile("s_waitcnt vmcnt(0)" ::: "memory");
        }
    }
    __syncthreads();
}

#ifndef ONE_LAUNCH
#define ONE_LAUNCH 1
#endif
__global__ void __launch_bounds__(NTHR, 2) fox_fwd(Params PA, int ph_lo, int ph_hi) {
    extern __shared__ __attribute__((aligned(16))) unsigned char lds_dyn[];
    char* lds = (char*)lds_dyn; PG8_LAS unsigned char* lds3 = (PG8_LAS unsigned char*)lds_dyn;
    const int tid = threadIdx.x, bid0 = blockIdx.x, nb0 = gridDim.x;
    LAS unsigned* ptab = (LAS unsigned*)(lds3 + LDS_PTAB);
    store_params(ptab, PA);
    if (tid < 256) ((LAS unsigned*)(lds3 + LDS_RING))[tid] = 0u;
    __syncthreads();
    XcdBarrier bar; bar.bar = (unsigned*)(PA.ws + WS_CTL) + CW_BAR; bar.x = 0; bar.st = nullptr;
    if (ph_hi - ph_lo > 1) bar = xcd_barrier_post((unsigned*)(PA.ws + WS_CTL) + CW_BAR, (volatile LAS unsigned*)(lds3 + LDS_MISC) + 8);
    __syncthreads();
#define PL const Params P = load_params(ptab); int bid = bid0, nb = nb0; asm volatile("" : "+s"(bid), "+s"(nb))
#define IN(k) (ph_lo <= (k) && (k) < ph_hi)
#define SEAM(k) do { if (IN((k) + 1)) { XcdBarrier xb_ = bar; asm volatile("" : "+s"(xb_.bar), "+s"(xb_.x));     \
        xcd_barrier(xb_); } } while (0)
    if (IN(0)) { PL; ph_prologue(P, lds, bid, nb); SEAM(0); }
    { constexpr int l = 0;
        const int pb = 1 + 8 * l;
        if (IN(pb + 0)) { PL; ph_norm<0, l == 0>(P, lds, l, bid, nb); SEAM(pb + 0); }
        if (IN(pb + 1)) { PL; pg8::Gemm g{WSP(bf16_t, WS_H), WSP(bf16_t, WS_WIN) + (size_t)l * NZ * DM, M, NZ, DM}; pg8::StaticOrder S; S.init(M, NZ, nb, bid);
            static_assert(WS_K - WS_Q == 2 * pg8::EpiZr::QKV_STRIDE && WS_V - WS_K == 2 * pg8::EpiZr::QKV_STRIDE, "Q | K | V spacing");
            pg8::EpiZr E{WSP(bf16_t, WS_ZP), WSP(bf16_t, WS_Q), WSP(bf16_t, WS_ZX), WSP(bf16_t, WS_ZY), WSP(unsigned, WS_CTL) + CW_NRM + l * 128, (PG8_LAS float*)(lds3 + LDS_RING + 8192)};
            pg8::gemm_phase<pg8::EpiZr, pg8::StaticOrder, true, true>(lds3, g, S, E);
            if (bid >= nb - 2) { const int w_ = opaque_tid() >> 6; for (int bh = (bid - (nb - 2)) * 8 + w_; bh < 16; bh += 16) fscan_wave(P, lds, bh); }
            { const int nun = (M / 256) * (NZ / 256), umax = (nun + nb - 1) / nb, first_short = nun - (umax - 1) * nb;
              if (l + 1 < DEPTH && first_short < nb && bid >= first_short) { __syncthreads(); ada_layer(P, lds, l + 1, bid - first_short, nb - first_short); }
              else if (l + 1 < DEPTH && first_short >= nb) { __syncthreads(); ada_layer(P, lds, l + 1, bid, nb); } }
            SEAM(pb + 1); }
        if (IN(pb + 2)) { PL; unsigned* ctl_ = WSP(unsigned, WS_CTL); ph_selfmin(P, lds, bid, nb); split_arrive(ctl_ + CW_SPLIT + 64 * l + 32);
            ph_mixprep(P, lds, l, bid, nb); split_arrive(ctl_ + CW_SPLIT + 64 * l); split_wait(ctl_ + CW_SPLIT + 64 * l + 32, (unsigned)nb, ctl_ + CW_BAR + XB_TMO);
            ph_attn(P, lds, l, bid, nb); __syncthreads(); split_wait(ctl_ + CW_SPLIT + 64 * l, (unsigned)nb, ctl_ + CW_BAR + XB_TMO);
            for (int u = bid; u < 256; u += nb) lru_fixup_tile(P, lds, u); SEAM(pb + 2); }
        if (IN(pb + 3)) { PL; ph_attn_combine(P, lds, bid, nb); SEAM(pb + 3); }
        if (IN(pb + 4)) { PL; const float* modl = WSP(float, WS_MOD) + (size_t)l * 2 * NADA; pg8::Gemm g{WSP(bf16_t, WS_Y), WSP(bf16_t, WS_WOUT) + (size_t)l * DM * DM, M, DM, DM}; pg8::StaticOrder S; S.init(M, DM, nb, bid);
            pg8::EpiResid<false> E{P.x_in, WSP(const _Float16, WS_XH), WSP(_Float16, WS_XH), modl + 2 * DM};
            pg8::gemm_phase<pg8::EpiResid<false>, pg8::StaticOrder, true, true>(lds3, g, S, E); SEAM(pb + 4); }
        if (IN(pb + 5)) { PL; ph_norm<1, false>(P, lds, l, bid, nb); SEAM(pb + 5); }
        if (IN(pb + 6)) { PL; pg8::Gemm g{WSP(bf16_t, WS_H), WSP(bf16_t, WS_WGU) + (size_t)l * NGU * DM, M, NGU, DM}; pg8::StaticOrder S; S.init(M, NGU, nb, bid);
            pg8::EpiGUAct E{WSP(bf16_t, WS_ACT), P.ffn_cw + (size_t)l * 3 * DFF, P.ffn_cb + l * DFF, WSP(float, WS_SIDE), (PG8_LAS float*)(lds3 + LDS_HALO)};
            pg8::gemm_phase<pg8::EpiGUAct, pg8::StaticOrder, true, true>(lds3, g, S, E); SEAM(pb + 6); }
        if (IN(pb + 7)) { PL; const float* modl = WSP(float, WS_MOD) + (size_t)l * 2 * NADA; pg8::Gemm g{WSP(bf16_t, WS_ACT), WSP(bf16_t, WS_WDN) + (size_t)l * DM * DFF, M, DM, DFF}; pg8::StaticOrder S; S.init(M, DM, nb, bid);
            { pg8::StaticOrder Sf; Sf.init(M, DM, nb, bid); pg8::Unit u0, u1; const bool h0 = Sf.next(0, u0), h1 = Sf.next(1, u1);
              if (nb * 2 >= (M / 256) * (DM / 256)) { if (h0) ffn_fix_tile(P, l, u0.pm); if (h1 && u1.pm != u0.pm) ffn_fix_tile(P, l, u1.pm); }
              else { for (int t = 0; t < M / 256; ++t) ffn_fix_tile(P, l, t); }
              asm volatile("s_waitcnt vmcnt(0)" ::: "memory"); __syncthreads(); }
            pg8::EpiResid<false> E{P.x_in, WSP(const _Float16, WS_XH), WSP(_Float16, WS_XH), modl + 5 * DM};
            pg8::gemm_phase<pg8::EpiResid<false>, pg8::StaticOrder, true, true>(lds3, g, S, E); SEAM(pb + 7); }
        }
    { constexpr int l = 1;
        const int pb = 1 + 8 * l;
        if (IN(pb + 0)) { PL; ph_norm<0, l == 0>(P, lds, l, bid, nb); SEAM(pb + 0); }
        if (IN(pb + 1)) { PL; pg8::Gemm g{WSP(bf16_t, WS_H), WSP(bf16_t, WS_WIN) + (size_t)l * NZ * DM, M, NZ, DM}; pg8::StaticOrder S; S.init(M, NZ, nb, bid);
            static_assert(WS_K - WS_Q == 2 * pg8::EpiZr::QKV_STRIDE && WS_V - WS_K == 2 * pg8::EpiZr::QKV_STRIDE, "Q | K | V spacing");
            pg8::EpiZr E{WSP(bf16_t, WS_ZP), WSP(bf16_t, WS_Q), WSP(bf16_t, WS_ZX), WSP(bf16_t, WS_ZY), WSP(unsigned, WS_CTL) + CW_NRM + l * 128, (PG8_LAS float*)(lds3 + LDS_RING + 8192)};
            pg8::gemm_phase<pg8::EpiZr, pg8::StaticOrder, true, true>(lds3, g, S, E);
            if (bid >= nb - 2) { const int w_ = opaque_tid() >> 6; for (int bh = (bid - (nb - 2)) * 8 + w_; bh < 16; bh += 16) fscan_wave(P, lds, bh); }
            { const int nun = (M / 256) * (NZ / 256), umax = (nun + nb - 1) / nb, first_short = nun - (umax - 1) * nb;
              if (l + 1 < DEPTH && first_short < nb && bid >= first_short) { __syncthreads(); ada_layer(P, lds, l + 1, bid - first_short, nb - first_short); }
              else if (l + 1 < DEPTH && first_short >= nb) { __syncthreads(); ada_layer(P, lds, l + 1, bid, nb); } }
            SEAM(pb + 1); }
        if (IN(pb + 2)) { PL; unsigned* ctl_ = WSP(unsigned, WS_CTL); ph_selfmin(P, lds, bid, nb); split_arrive(ctl_ + CW_SPLIT + 64 * l + 32);
            ph_mixprep(P, lds, l, bid, nb); split_arrive(ctl_ + CW_SPLIT + 64 * l); split_wait(ctl_ + CW_SPLIT + 64 * l + 32, (unsigned)nb, ctl_ + CW_BAR + XB_TMO);
            ph_attn(P, lds, l, bid, nb); __syncthreads(); split_wait(ctl_ + CW_SPLIT + 64 * l, (unsigned)nb, ctl_ + CW_BAR + XB_TMO);
            for (int u = bid; u < 256; u += nb) lru_fixup_tile(P, lds, u); SEAM(pb + 2); }
        if (IN(pb + 3)) { PL; ph_attn_combine(P, lds, bid, nb); SEAM(pb + 3); }
        if (IN(pb + 4)) { PL; const float* modl = WSP(float, WS_MOD) + (size_t)l * 2 * NADA; pg8::Gemm g{WSP(bf16_t, WS_Y), WSP(bf16_t, WS_WOUT) + (size_t)l * DM * DM, M, DM, DM}; pg8::StaticOrder S; S.init(M, DM, nb, bid);
            pg8::EpiResid<false> E{P.x_in, WSP(const _Float16, WS_XH), WSP(_Float16, WS_XH), modl + 2 * DM};
            pg8::gemm_phase<pg8::EpiResid<false>, pg8::StaticOrder, true, true>(lds3, g, S, E); SEAM(pb + 4); }
        if (IN(pb + 5)) { PL; ph_norm<1, false>(P, lds, l, bid, nb); SEAM(pb + 5); }
        if (IN(pb + 6)) { PL; pg8::Gemm g{WSP(bf16_t, WS_H), WSP(bf16_t, WS_WGU) + (size_t)l * NGU * DM, M, NGU, DM}; pg8::StaticOrder S; S.init(M, NGU, nb, bid);
            pg8::EpiGUAct E{WSP(bf16_t, WS_ACT), P.ffn_cw + (size_t)l * 3 * DFF, P.ffn_cb + l * DFF, WSP(float, WS_SIDE), (PG8_LAS float*)(lds3 + LDS_HALO)};
            pg8::gemm_phase<pg8::EpiGUAct, pg8::StaticOrder, true, true>(lds3, g, S, E); SEAM(pb + 6); }
        if (IN(pb + 7)) { PL; const float* modl = WSP(float, WS_MOD) + (size_t)l * 2 * NADA; pg8::Gemm g{WSP(bf16_t, WS_ACT), WSP(bf16_t, WS_WDN) + (size_t)l * DM * DFF, M, DM, DFF}; pg8::StaticOrder S; S.init(M, DM, nb, bid);
            { pg8::StaticOrder Sf; Sf.init(M, DM, nb, bid); pg8::Unit u0, u1; const bool h0 = Sf.next(0, u0), h1 = Sf.next(1, u1);
              if (nb * 2 >= (M / 256) * (DM / 256)) { if (h0) ffn_fix_tile(P, l, u0.pm); if (h1 && u1.pm != u0.pm) ffn_fix_tile(P, l, u1.pm); }
              else { for (int t = 0; t < M / 256; ++t) ffn_fix_tile(P, l, t); }
              asm volatile("s_waitcnt vmcnt(0)" ::: "memory"); __syncthreads(); }
            pg8::EpiResid<false> E{P.x_in, WSP(const _Float16, WS_XH), WSP(_Float16, WS_XH), modl + 5 * DM};
            pg8::gemm_phase<pg8::EpiResid<false>, pg8::StaticOrder, true, true>(lds3, g, S, E); SEAM(pb + 7); }
        }
    { constexpr int l = 2;
        const int pb = 1 + 8 * l;
        if (IN(pb + 0)) { PL; ph_norm<0, l == 0>(P, lds, l, bid, nb); SEAM(pb + 0); }
        if (IN(pb + 1)) { PL; pg8::Gemm g{WSP(bf16_t, WS_H), WSP(bf16_t, WS_WIN) + (size_t)l * NZ * DM, M, NZ, DM}; pg8::StaticOrder S; S.init(M, NZ, nb, bid);
            static_assert(WS_K - WS_Q == 2 * pg8::EpiZr::QKV_STRIDE && WS_V - WS_K == 2 * pg8::EpiZr::QKV_STRIDE, "Q | K | V spacing");
            pg8::EpiZr E{WSP(bf16_t, WS_ZP), WSP(bf16_t, WS_Q), WSP(bf16_t, WS_ZX), WSP(bf16_t, WS_ZY), WSP(unsigned, WS_CTL) + CW_NRM + l * 128, (PG8_LAS float*)(lds3 + LDS_RING + 8192)};
            pg8::gemm_phase<pg8::EpiZr, pg8::StaticOrder, true, true>(lds3, g, S, E);
            if (bid >= nb - 2) { const int w_ = opaque_tid() >> 6; for (int bh = (bid - (nb - 2)) * 8 + w_; bh < 16; bh += 16) fscan_wave(P, lds, bh); }
            { const int nun = (M / 256) * (NZ / 256), umax = (nun + nb - 1) / nb, first_short = nun - (umax - 1) * nb;
              if (l + 1 < DEPTH && first_short < nb && bid >= first_short) { __syncthreads(); ada_layer(P, lds, l + 1, bid - first_short, nb - first_short); }
              else if (l + 1 < DEPTH && first_short >= nb) { __syncthreads(); ada_layer(P, lds, l + 1, bid, nb); } }
            SEAM(pb + 1); }
        if (IN(pb + 2)) { PL; unsigned* ctl_ = WSP(unsigned, WS_CTL); ph_selfmin(P, lds, bid, nb); split_arrive(ctl_ + CW_SPLIT + 64 * l + 32);
            ph_mixprep(P, lds, l, bid, nb); split_arrive(ctl_ + CW_SPLIT + 64 * l); split_wait(ctl_ + CW_SPLIT + 64 * l + 32, (unsigned)nb, ctl_ + CW_BAR + XB_TMO);
            ph_attn(P, lds, l, bid, nb); __syncthreads(); split_wait(ctl_ + CW_SPLIT + 64 * l, (unsigned)nb, ctl_ + CW_BAR + XB_TMO);
            for (int u = bid; u < 256; u += nb) lru_fixup_tile(P, lds, u); SEAM(pb + 2); }
        if (IN(pb + 3)) { PL; ph_attn_combine(P, lds, bid, nb); SEAM(pb + 3); }
        if (IN(pb + 4)) { PL; const float* modl = WSP(float, WS_MOD) + (size_t)l * 2 * NADA; pg8::Gemm g{WSP(bf16_t, WS_Y), WSP(bf16_t, WS_WOUT) + (size_t)l * DM * DM, M, DM, DM}; pg8::StaticOrder S; S.init(M, DM, nb, bid);
            pg8::EpiResid<false> E{P.x_in, WSP(const _Float16, WS_XH), WSP(_Float16, WS_XH), modl + 2 * DM};
            pg8::gemm_phase<pg8::EpiResid<false>, pg8::StaticOrder, true, true>(lds3, g, S, E); SEAM(pb + 4); }
        if (IN(pb + 5)) { PL; ph_norm<1, false>(P, lds, l, bid, nb); SEAM(pb + 5); }
        if (IN(pb + 6)) { PL; pg8::Gemm g{WSP(bf16_t, WS_H), WSP(bf16_t, WS_WGU) + (size_t)l * NGU * DM, M, NGU, DM}; pg8::StaticOrder S; S.init(M, NGU, nb, bid);
            pg8::EpiGUAct E{WSP(bf16_t, WS_ACT), P.ffn_cw + (size_t)l * 3 * DFF, P.ffn_cb + l * DFF, WSP(float, WS_SIDE), (PG8_LAS float*)(lds3 + LDS_HALO)};
            pg8::gemm_phase<pg8::EpiGUAct, pg8::StaticOrder, true, true>(lds3, g, S, E); SEAM(pb + 6); }
        if (IN(pb + 7)) { PL; const float* modl = WSP(float, WS_MOD) + (size_t)l * 2 * NADA; pg8::Gemm g{WSP(bf16_t, WS_ACT), WSP(bf16_t, WS_WDN) + (size_t)l * DM * DFF, M, DM, DFF}; pg8::StaticOrder S; S.init(M, DM, nb, bid);
            { pg8::StaticOrder Sf; Sf.init(M, DM, nb, bid); pg8::Unit u0, u1; const bool h0 = Sf.next(0, u0), h1 = Sf.next(1, u1);
              if (nb * 2 >= (M / 256) * (DM / 256)) { if (h0) ffn_fix_tile(P, l, u0.pm); if (h1 && u1.pm != u0.pm) ffn_fix_tile(P, l, u1.pm); }
              else { for (int t = 0; t < M / 256; ++t) ffn_fix_tile(P, l, t); }
              asm volatile("s_waitcnt vmcnt(0)" ::: "memory"); __syncthreads(); }
            pg8::EpiResid<false> E{P.x_in, WSP(const _Float16, WS_XH), WSP(_Float16, WS_XH), modl + 5 * DM};
            pg8::gemm_phase<pg8::EpiResid<false>, pg8::StaticOrder, true, true>(lds3, g, S, E); SEAM(pb + 7); }
        }
    { constexpr int l = 3;
        const int pb = 1 + 8 * l;
        if (IN(pb + 0)) { PL; ph_norm<0, l == 0>(P, lds, l, bid, nb); SEAM(pb + 0); }
        if (IN(pb + 1)) { PL; pg8::Gemm g{WSP(bf16_t, WS_H), WSP(bf16_t, WS_WIN) + (size_t)l * NZ * DM, M, NZ, DM}; pg8::StaticOrder S; S.init(M, NZ, nb, bid);
            static_assert(WS_K - WS_Q == 2 * pg8::EpiZr::QKV_STRIDE && WS_V - WS_K == 2 * pg8::EpiZr::QKV_STRIDE, "Q | K | V spacing");
            pg8::EpiZr E{WSP(bf16_t, WS_ZP), WSP(bf16_t, WS_Q), WSP(bf16_t, WS_ZX), WSP(bf16_t, WS_ZY), WSP(unsigned, WS_CTL) + CW_NRM + l * 128, (PG8_LAS float*)(lds3 + LDS_RING + 8192)};
            pg8::gemm_phase<pg8::EpiZr, pg8::StaticOrder, true, true>(lds3, g, S, E);
            if (bid >= nb - 2) { const int w_ = opaque_tid() >> 6; for (int bh = (bid - (nb - 2)) * 8 + w_; bh < 16; bh += 16) fscan_wave(P, lds, bh); }
            { const int nun = (M / 256) * (NZ / 256), umax = (nun + nb - 1) / nb, first_short = nun - (umax - 1) * nb;
              if (l + 1 < DEPTH && first_short < nb && bid >= first_short) { __syncthreads(); ada_layer(P, lds, l + 1, bid - first_short, nb - first_short); }
              else if (l + 1 < DEPTH && first_short >= nb) { __syncthreads(); ada_layer(P, lds, l + 1, bid, nb); } }
            SEAM(pb + 1); }
        if (IN(pb + 2)) { PL; unsigned* ctl_ = WSP(unsigned, WS_CTL); ph_selfmin(P, lds, bid, nb); split_arrive(ctl_ + CW_SPLIT + 64 * l + 32);
            ph_mixprep(P, lds, l, bid, nb); split_arrive(ctl_ + CW_SPLIT + 64 * l); split_wait(ctl_ + CW_SPLIT + 64 * l + 32, (unsigned)nb, ctl_ + CW_BAR + XB_TMO);
            ph_attn(P, lds, l, bid, nb); __syncthreads(); split_wait(ctl_ + CW_SPLIT + 64 * l, (unsigned)nb, ctl_ + CW_BAR + XB_TMO);
            for (int u = bid; u < 256; u += nb) lru_fixup_tile(P, lds, u); SEAM(pb + 2); }
        if (IN(pb + 3)) { PL; ph_attn_combine(P, lds, bid, nb); SEAM(pb + 3); }
        if (IN(pb + 4)) { PL; const float* modl = WSP(float, WS_MOD) + (size_t)l * 2 * NADA; pg8::Gemm g{WSP(bf16_t, WS_Y), WSP(bf16_t, WS_WOUT) + (size_t)l * DM * DM, M, DM, DM}; pg8::StaticOrder S; S.init(M, DM, nb, bid);
            pg8::EpiResid<false> E{P.x_in, WSP(const _Float16, WS_XH), WSP(_Float16, WS_XH), modl + 2 * DM};
            pg8::gemm_phase<pg8::EpiResid<false>, pg8::StaticOrder, true, true>(lds3, g, S, E); SEAM(pb + 4); }
        if (IN(pb + 5)) { PL; ph_norm<1, false>(P, lds, l, bid, nb); SEAM(pb + 5); }
        if (IN(pb + 6)) { PL; pg8::Gemm g{WSP(bf16_t, WS_H), WSP(bf16_t, WS_WGU) + (size_t)l * NGU * DM, M, NGU, DM}; pg8::StaticOrder S; S.init(M, NGU, nb, bid);
            pg8::EpiGUAct E{WSP(bf16_t, WS_ACT), P.ffn_cw + (size_t)l * 3 * DFF, P.ffn_cb + l * DFF, WSP(float, WS_SIDE), (PG8_LAS float*)(lds3 + LDS_HALO)};
            pg8::gemm_phase<pg8::EpiGUAct, pg8::StaticOrder, true, true>(lds3, g, S, E); SEAM(pb + 6); }
        if (IN(pb + 7)) { PL; const float* modl = WSP(float, WS_MOD) + (size_t)l * 2 * NADA; pg8::Gemm g{WSP(bf16_t, WS_ACT), WSP(bf16_t, WS_WDN) + (size_t)l * DM * DFF, M, DM, DFF}; pg8::StaticOrder S; S.init(M, DM, nb, bid);
            { pg8::StaticOrder Sf; Sf.init(M, DM, nb, bid); pg8::Unit u0, u1; const bool h0 = Sf.next(0, u0), h1 = Sf.next(1, u1);
              if (nb * 2 >= (M / 256) * (DM / 256)) { if (h0) ffn_fix_tile(P, l, u0.pm); if (h1 && u1.pm != u0.pm) ffn_fix_tile(P, l, u1.pm); }
              else { for (int t = 0; t < M / 256; ++t) ffn_fix_tile(P, l, t); }
              asm volatile("s_waitcnt vmcnt(0)" ::: "memory"); __syncthreads(); }
            pg8::EpiResid<false> E{P.x_in, WSP(const _Float16, WS_XH), WSP(_Float16, WS_XH), modl + 5 * DM};
            pg8::gemm_phase<pg8::EpiResid<false>, pg8::StaticOrder, true, true>(lds3, g, S, E); SEAM(pb + 7); }
        }
    if (IN(NPH - 1)) { PL; ph_finalnorm(P, bid, nb); }
#undef IN
#undef SEAM
#undef PL
}

extern "C" void kernel_launch(void* const* d_in, const int* in_sizes, int n_in, void* d_out, int out_size, void* d_ws, size_t ws_size, hipStream_t stream) {
    static int grid = 0;
    if (grid == 0) {
        if (n_in != 24 || out_size != M * DM || ws_size < WS_END) { fprintf(stderr, "kernel_launch: unexpected shapes (n_in %d out %d ws %zu)\n", n_in, out_size, ws_size); grid = -1; return; }
        int dev = 0, cus = 0;
        if (hipGetDevice(&dev) != hipSuccess || hipDeviceGetAttribute(&cus, hipDeviceAttributeMultiprocessorCount, dev) != hipSuccess || cus <= 0) cus = 256;
        if (hipFuncSetAttribute((const void*)fox_fwd, hipFuncAttributeMaxDynamicSharedMemorySize, LDS_TOTAL) != hipSuccess) { fprintf(stderr, "kernel_launch: hipFuncSetAttribute failed\n"); grid = -1; return; }
        (void)hipGetLastError();
        grid = cus < 256 ? cus : 256;
    }
    if (grid < 0) return;
    static_assert((CW_NRM + DEPTH * 128) * 4 <= 65536 && (CW_SPLIT + 64 * DEPTH) * 4 <= 65536 && (CW_BAR + XCD_BAR_WORDS) * 4 <= 65536, "control words inside the zeroed 64 KiB");
    (void)hipMemsetAsync((char*)d_ws + WS_CTL, 0, 65536, stream);
    Params p; memset(&p, 0, sizeof(p));
    const float* const* in = (const float* const*)d_in;
    p.x_in = in[0]; p.c = in[1]; p.w_ada = in[2]; p.b_ada = in[3]; p.g_mix = in[4]; p.w_in = in[5]; p.b_f = in[6]; p.pool_w = in[7]; p.pool_scale = in[8];
    p.lru_cw = in[9]; p.lru_cb = in[10]; p.lru_wa = in[11]; p.lru_ba = in[12]; p.lru_wi = in[13]; p.lru_bi = in[14]; p.lru_lam = in[15]; p.w_out = in[16]; p.g_ffn = in[17];
    p.w_gate = in[18]; p.w_up = in[19]; p.ffn_cw = in[20]; p.ffn_cb = in[21]; p.w_down = in[22]; p.final_g = in[23];
    p.out = (float*)d_out; p.ws = (unsigned char*)d_ws;
#if ONE_LAUNCH
    fox_fwd<<<grid, NTHR, LDS_TOTAL, stream>>>(p, 0, NPH);
#else
    for (int k = 0; k < NPH; ++k) fox_fwd<<<grid, NTHR, LDS_TOTAL, stream>>>(p, k, k + 1);
#endif
}
```
